# Optimizing an MI355X kernel written in HIP

```python
import math
import jax, jax.numpy as jnp
from jax import lax
import numpy as np

D_MODEL = 1024
BATCH = 8
SEQ = 2048
DEPTH = 2

CHUNK = 64
N_META = 16
BLOCK_Q = 128
N_PAD = BLOCK_Q - N_META
N_MIXERS = 2
D_FF = 2816
RMS_EPS = 1e-6
NEG_INF = -1e30
DA_HEADS = 8
DA_HEAD_DIM = D_MODEL // DA_HEADS // 2
DA_V_DIM = 2 * DA_HEAD_DIM
DA_QK_WIDTH = DA_HEADS * 2 * DA_HEAD_DIM
DA_IN_WIDTH = 2 * DA_QK_WIDTH + DA_HEADS * DA_V_DIM
GLA_HEADS = 4
GLA_KEY_WIDTH = D_MODEL // 2
GLA_VAL_WIDTH = D_MODEL
GLA_DK = GLA_KEY_WIDTH // GLA_HEADS
GLA_DV = GLA_VAL_WIDTH // GLA_HEADS
GLA_GATE_RANK = 16
GLA_GATE_NORM = 16.0
GLA_IN_WIDTH = 2 * GLA_KEY_WIDTH + 2 * GLA_VAL_WIDTH + GLA_GATE_RANK
N_A = (DEPTH + 1) // 2
N_B = DEPTH // 2

kernel_name = "hybrid_diffattn_gla_macaron"


def rmsnorm(x, g):
    xf = x.astype(jnp.float32)
    y = xf * lax.rsqrt(jnp.mean(xf * xf, axis=-1, keepdims=True) + RMS_EPS)
    return (y * g.astype(jnp.float32)).astype(x.dtype)


def swiglu(h, w_in, w_out):
    gu = h @ w_in
    g, u = gu[..., :D_FF], gu[..., D_FF:]
    return (jax.nn.silu(g) * u) @ w_out


def pad_front(h):
    return jnp.pad(h, ((0, 0), (N_PAD, 0), (0, 0)))


def diff_attention(h, w_in, lam_p, subln_g, w_out, lam_init):
    B, L, _ = h.shape
    hp = pad_front(h)
    P = hp.shape[1]
    qkv = hp @ w_in
    q = qkv[..., :DA_QK_WIDTH].reshape(B, P, DA_HEADS, 2, DA_HEAD_DIM).transpose(0, 3, 2, 1, 4)
    k = qkv[..., DA_QK_WIDTH:2 * DA_QK_WIDTH].reshape(B, P, DA_HEADS, 2, DA_HEAD_DIM).transpose(0, 3, 2, 1, 4)
    v = qkv[..., 2 * DA_QK_WIDTH:].reshape(B, P, DA_HEADS, DA_V_DIM).transpose(0, 2, 1, 3)
    lp = lam_p.astype(jnp.float32)
    lam = jnp.exp(jnp.sum(lp[0] * lp[1])) - jnp.exp(jnp.sum(lp[2] * lp[3])) + lam_init
    pos = jnp.arange(P)
    chunk_id = pos // CHUNK
    k_valid = pos >= N_PAD
    scale = DA_HEAD_DIM ** -0.5
    outs = []
    for s in range(0, P, BLOCK_Q):
        e = s + BLOCK_Q
        sc = jnp.einsum('bmhqd,bmhkd->bmhqk', q[:, :, :, s:e], k[:, :, :, :e]).astype(jnp.float32) * scale
        allowed = k_valid[None, :e] & (chunk_id[None, :e] <= chunk_id[s:e, None])
        p = jax.nn.softmax(jnp.where(allowed, sc, NEG_INF), axis=-1)
        a = p[:, 0] - lam * p[:, 1]
        outs.append(jnp.einsum('bhqk,bhkv->bhqv', a.astype(v.dtype), v[:, :, :e]))
    o = jnp.concatenate(outs, axis=2)[:, :, N_PAD:]
    o = rmsnorm(o, subln_g) * (1.0 - lam_init)
    return o.transpose(0, 2, 1, 3).reshape(B, L, DA_HEADS * DA_V_DIM) @ w_out


def gla_mixer(h, w_in, w_gate2, b_gate2, norm_g, w_out):
    B, L, _ = h.shape
    hp = pad_front(h)
    P = hp.shape[1]
    NC = P // CHUNK
    proj = hp @ w_in
    o1 = GLA_KEY_WIDTH
    o2 = 2 * GLA_KEY_WIDTH
    o3 = o2 + GLA_VAL_WIDTH
    o4 = o3 + GLA_VAL_WIDTH
    q, k, v, og, glr = proj[..., :o1], proj[..., o1:o2], proj[..., o2:o3], proj[..., o3:o4], proj[..., o4:]
    gk = jax.nn.log_sigmoid((glr @ w_gate2 + b_gate2).astype(jnp.float32)) / GLA_GATE_NORM
    valid = (jnp.arange(P) >= N_PAD)[None, :, None]
    gk = jnp.where(valid, gk, 0.0)
    q = (q.astype(jnp.float32) * GLA_DK ** -0.5).reshape(B, NC, CHUNK, GLA_HEADS, GLA_DK)
    k = k.astype(jnp.float32).reshape(B, NC, CHUNK, GLA_HEADS, GLA_DK)
    v = v.astype(jnp.float32).reshape(B, NC, CHUNK, GLA_HEADS, GLA_DV)
    G = jnp.cumsum(gk.reshape(B, NC, CHUNK, GLA_HEADS, GLA_DK), axis=2)
    G_end = G[:, :, -1:]
    k_dec = k * jnp.exp(G_end - G)
    kv = jnp.einsum('bnchk,bnchv->bnhkv', k_dec, v)
    decay = jnp.exp(G_end[:, :, 0])

    def step(S, inp):
        kv_c, d_c, q_c = inp
        S = d_c[..., None] * S + kv_c
        return S, jnp.einsum('bchk,bhkv->bchv', q_c, S)

    S0 = jnp.zeros((B, GLA_HEADS, GLA_DK, GLA_DV), jnp.float32)
    _, o = lax.scan(step, S0, (jnp.moveaxis(kv, 1, 0), jnp.moveaxis(decay, 1, 0), jnp.moveaxis(q, 1, 0)))
    o = jnp.moveaxis(o, 0, 1).reshape(B, P, GLA_HEADS, GLA_DV)[:, N_PAD:].astype(h.dtype)
    gate = jax.nn.silu(og[:, N_PAD:].reshape(B, L, GLA_HEADS, GLA_DV))
    o = rmsnorm(o, norm_g) * gate
    return o.reshape(B, L, GLA_VAL_WIDTH) @ w_out


def setup_inputs(seed: int = 0) -> dict:
    key = jax.random.key(seed)
    ks = jax.random.split(key, 24)
    nrm = lambda k, shape, fan_in: jax.random.normal(k, shape, jnp.float32) * fan_in ** -0.5
    gain = lambda k, shape: 1.0 + 0.02 * jax.random.normal(k, shape, jnp.float32)
    return {
        "x": jax.random.normal(ks[0], (BATCH, SEQ, D_MODEL), jnp.float32),
        "meta": jax.random.normal(ks[1], (N_META, D_MODEL), jnp.float32),
        "ffn1_norm": gain(ks[2], (DEPTH, D_MODEL)),
        "ffn1_w_in": nrm(ks[3], (DEPTH, D_MODEL, 2 * D_FF), D_MODEL),
        "ffn1_w_out": nrm(ks[4], (DEPTH, D_FF, D_MODEL), D_FF),
        "mix_norm": gain(ks[5], (DEPTH, D_MODEL)),
        "ffn2_norm": gain(ks[6], (DEPTH, D_MODEL)),
        "ffn2_w_in": nrm(ks[7], (DEPTH, D_MODEL, 2 * D_FF), D_MODEL),
        "ffn2_w_out": nrm(ks[8], (DEPTH, D_FF, D_MODEL), D_FF),
        "da_w_in": nrm(ks[9], (N_A, D_MODEL, DA_IN_WIDTH), D_MODEL),
        "da_lambda": 0.1 * jax.random.normal(ks[10], (N_A, 4, DA_HEAD_DIM), jnp.float32),
        "da_subln": gain(ks[11], (N_A, DA_V_DIM)),
        "da_w_out": nrm(ks[12], (N_A, DA_HEADS * DA_V_DIM, D_MODEL), DA_HEADS * DA_V_DIM),
        "gla_w_in": nrm(ks[13], (N_B, D_MODEL, GLA_IN_WIDTH), D_MODEL),
        "gla_w_gate2": nrm(ks[14], (N_B, GLA_GATE_RANK, GLA_KEY_WIDTH), GLA_GATE_RANK),
        "gla_b_gate2": 0.1 * jax.random.normal(ks[15], (N_B, GLA_KEY_WIDTH), jnp.float32),
        "gla_norm": gain(ks[16], (N_B, GLA_DV)),
        "gla_w_out": nrm(ks[17], (N_B, GLA_VAL_WIDTH, D_MODEL), GLA_VAL_WIDTH),
        "final_norm": gain(ks[18], (D_MODEL,)),
    }


def reference(x, meta, ffn1_norm, ffn1_w_in, ffn1_w_out, mix_norm, ffn2_norm, ffn2_w_in, ffn2_w_out,
              da_w_in, da_lambda, da_subln, da_w_out,
              gla_w_in, gla_w_gate2, gla_b_gate2, gla_norm, gla_w_out, final_norm):
    B = x.shape[0]
    meta_b = jnp.broadcast_to(meta[None].astype(x.dtype), (B, N_META, D_MODEL))
    h = jnp.concatenate([meta_b, x], axis=1)
    for i in range(DEPTH):
        h = h + 0.5 * swiglu(rmsnorm(h, ffn1_norm[i]), ffn1_w_in[i], ffn1_w_out[i])
        hn = rmsnorm(h, mix_norm[i])
        j = i // N_MIXERS
        if i % N_MIXERS == 0:
            lam_init = 0.8 - 0.6 * math.exp(-0.3 * i)
            h = h + diff_attention(hn, da_w_in[j], da_lambda[j], da_subln[j], da_w_out[j], lam_init)
        else:
            h = h + gla_mixer(hn, gla_w_in[j], gla_w_gate2[j], gla_b_gate2[j], gla_norm[j], gla_w_out[j])
        h = h + 0.5 * swiglu(rmsnorm(h, ffn2_norm[i]), ffn2_w_in[i], ffn2_w_out[i])
    return rmsnorm(h, final_norm)[:, N_META:]
```

```cpp
#include <hip/hip_runtime.h>
#include <hip/hip_cooperative_groups.h>
#include <cstdio>
#include <cstring>
namespace cg = cooperative_groups;

#define LAS __attribute__((address_space(3)))
typedef unsigned short bf16_t;
typedef short bf16x8 __attribute__((ext_vector_type(8)));
typedef float f32x4 __attribute__((ext_vector_type(4)));
typedef float f32x2 __attribute__((ext_vector_type(2)));
typedef unsigned u32x4 __attribute__((ext_vector_type(4)));
typedef unsigned u32x2 __attribute__((ext_vector_type(2)));

constexpr int D = 1024, NB = 8, SEQ = 2048, DFF = 2816;
constexpr int MX = NB * SEQ;
constexpr int MMETA = NB * 16;
constexpr int MTOT = MX + MMETA;
constexpr int MP = 16640;
constexpr int LDS_BYTES = 131072;
constexpr int LDS_TOTAL = LDS_BYTES + 16;
constexpr float RMS_EPS = 1e-6f;
#define XCNT_WORDS (6 * 64 * 64 + 6 * 64)

typedef __bf16 bf16x2_t __attribute__((ext_vector_type(2)));
__device__ __forceinline__ unsigned cvt_pk_bf16(float lo, float hi) { const f32x2 v = {lo, hi}; const bf16x2_t b = __builtin_convertvector(v, bf16x2_t); return __builtin_bit_cast(unsigned, b); }
__device__ __forceinline__ void store_wt16(void* p, u32x4 v) { asm volatile("global_store_dwordx4 %0, %1, off sc1\n\ts_nop 1" :: "v"(p), "v"(v) : "memory"); }
__device__ __forceinline__ float bf2f(unsigned short b) { return __uint_as_float(((unsigned)b) << 16); }
__device__ __forceinline__ float bflo(unsigned w) { return __uint_as_float(w << 16); }
__device__ __forceinline__ float bfhi(unsigned w) { return __uint_as_float(w & 0xffff0000u); }

namespace pg8 {
constexpr int BM = 256, BK = 64, HALF = 128, HTB = HALF * BK * 2, STAGE_BYTES = 8 * HTB, NXCD = 8, WGM = 8;
__host__ __device__ __forceinline__ int lds_byte(int r, int c) { const int st = (r >> 4) * 2 + (c >> 5), rr = r & 15, cc = c & 31, ob = rr * 64 + cc * 2; return st * 1024 + (ob ^ (((ob >> 9) & 1) << 5)); }
__host__ __device__ __forceinline__ void stage_rc(int b, int& R, int& C) { const int st = b / 1024, sb = b % 1024, swz = sb ^ (((sb >> 9) & 1) << 5); R = (st >> 1) * 16 + swz / 64; C = (st & 1) * 32 + (swz % 64) / 2; }
__host__ __device__ __forceinline__ int perm32(int rho) { const int n = rho >> 4, i = rho & 15; return 8 * (i >> 2) + 4 * n + (i & 3); }

struct Unit { int pm, pn; };
struct Gemm { const bf16_t* A; const bf16_t* Bt; int M, N, K, lda; };
struct StaticOrder {
    int nM, nN, nwg, G, c, mode;
    __device__ void init(int M, int N, int G_, int c_, int mode_ = 0) { nM = M / BM; nN = N / BM; nwg = nM * nN; G = G_; c = c_; mode = mode_; }
    __device__ bool split_tail() const { const int rem = nwg % G; return rem > 0 && 2 * rem <= G; }
    __device__ bool next(int i, Unit& u) const {
        long L;
        if (mode == 2) { const int full = nwg / G, rem = nwg - full * G; if (i != 0 || c >= 2 * rem) return false; L = (long)full * G + (c >> 1); }
        else { L = (long)i * G + c; if (L >= nwg) return false; if (mode == 1 && i >= nwg / G) return false; }
        int wgid = (int)L; { const int q = nwg / NXCD, r = nwg % NXCD, xcd = wgid % NXCD, off = wgid / NXCD; wgid = (xcd < r ? xcd * (q + 1) : r * (q + 1) + (xcd - r) * q) + off; }
        const int nig = WGM * nN, gid = wgid / nig, fm = gid * WGM, gsz = (nM - fm) < WGM ? (nM - fm) : WGM;
        u.pm = fm + ((wgid % nig) % gsz); u.pn = (wgid % nig) / gsz; return true;
    }
};

template <class Epi, int HSEL = 0>
__device__ __forceinline__ void gemm_phase(LAS unsigned char* lds, const Gemm g, const StaticOrder& S, const Epi& E) {
    const int tid = threadIdx.x, wid = __builtin_amdgcn_readfirstlane(tid >> 6), lane = tid & 63, wr = wid >> 2, wc = wid & 3, fr = lane & 15, fq = lane >> 4;
    const int K = g.K, nt = K / BK;
    unsigned voffA[2], voffB[2];
#pragma unroll
    for (int i = 0; i < 2; ++i) { int R, C; stage_rc(tid * 16 + i * 8192, R, C); const int Rb = Epi::PERM ? ((R & ~31) + perm32(R & 31)) : R;
        voffA[i] = (unsigned)(R * g.lda + C) * 2u; voffB[i] = (unsigned)(Rb * K + C) * 2u; }
    const size_t kstep = (size_t)(BK * 2);
    const size_t hstep = (size_t)HALF * K * 2, hstepA = (size_t)HALF * g.lda * 2;
    const size_t tstep = 2 * hstep, tstepA = 2 * hstepA;
    const unsigned ldsw = (unsigned)wid * 1024u;
    const int aoff = lds_byte(wr * 64 + fr, fq * 8), boff = lds_byte(wc * 32 + fr, fq * 8);
#define PG8_SA(b, h) (((b) * 2 + (h)) * HTB)
#define PG8_SB(b, h) ((4 + (b) * 2 + (h)) * HTB)
#define PG8_STAGE(bufoff, gbase, voff) do { _Pragma("unroll") for (int _i = 0; _i < 2; ++_i) \
        __builtin_amdgcn_global_load_lds((const unsigned*)((const char*)(gbase) + (voff)[_i]), (LAS unsigned*)(lds + (bufoff) + ldsw + _i * 8192), 16, 0, 0); } while (0)
#define PG8_LDA(dst, b, h) do { _Pragma("unroll") for (int m = 0; m < 4; ++m) _Pragma("unroll") for (int k = 0; k < 2; ++k) dst[m][k] = *(const LAS bf16x8*)(lds + PG8_SA(b, h) + aoff + m * 2048 + k * 1024); } while (0)
#define PG8_LDB(dst, b, h) do { _Pragma("unroll") for (int n = 0; n < 2; ++n) _Pragma("unroll") for (int k = 0; k < 2; ++k) dst[n][k] = *(const LAS bf16x8*)(lds + PG8_SB(b, h) + boff + n * 2048 + k * 1024); } while (0)
#define PG8_MMA(ai, bj, At, Bt) do { __builtin_amdgcn_s_setprio(1); _Pragma("unroll") for (int m = 0; m < 4; ++m) _Pragma("unroll") for (int n = 0; n < 2; ++n) _Pragma("unroll") for (int k = 0; k < 2; ++k) \
        acc[ai][bj][m][n] = __builtin_amdgcn_mfma_f32_16x16x32_bf16(Bt[n][k], At[m][k], acc[ai][bj][m][n], 0, 0, 0); __builtin_amdgcn_s_setprio(0); } while (0)
#define PG8_KEEPA(X) do { _Pragma("unroll") for (int m = 0; m < 4; ++m) _Pragma("unroll") for (int k = 0; k < 2; ++k) asm volatile("" :: "v"(X[m][k])); } while (0)
#define PG8_WAIT_V(n) asm volatile("s_waitcnt vmcnt(" #n ")" ::: "memory")
#define PG8_WAIT_L(n) asm volatile("s_waitcnt lgkmcnt(" #n ")" ::: "memory")
#define PG8_BAR __builtin_amdgcn_s_barrier()
#define PG8_SCHED __builtin_amdgcn_sched_barrier(0)
    Unit cur, nxt; int ui = 0;
    if (!S.next(0, cur)) return;
    f32x4 acc[2][2][4][2];
#pragma unroll
    for (int a = 0; a < 2; ++a)
#pragma unroll
        for (int b = 0; b < 2; ++b)
#pragma unroll
            for (int m = 0; m < 4; ++m)
#pragma unroll
                for (int n = 0; n < 2; ++n) acc[a][b][m][n] = (f32x4){0.f, 0.f, 0.f, 0.f};
    bf16x8 At[4][2], B0[2][2], B1[2][2];
    const char* cA = (const char*)g.A + (size_t)cur.pm * tstepA; const char* cB = (const char*)g.Bt + (size_t)cur.pn * tstep;
    PG8_STAGE(PG8_SB(0, 0), cB, voffB); PG8_STAGE(PG8_SA(0, 0), cA, voffA); PG8_STAGE(PG8_SB(0, 1), cB + hstep, voffB); PG8_STAGE(PG8_SA(0, 1), cA + hstepA, voffA);
    if (wr == 1) PG8_BAR;
    PG8_WAIT_V(4); PG8_BAR;
    PG8_STAGE(PG8_SB(1, 0), cB + kstep, voffB); PG8_STAGE(PG8_SA(1, 0), cA + kstep, voffA); PG8_STAGE(PG8_SB(1, 1), cB + hstep + kstep, voffB);
    PG8_WAIT_V(6); PG8_BAR;
    for (;;) {
        const bool has_next = S.next(ui + 1, nxt);
        const char* nA = has_next ? (const char*)g.A + (size_t)nxt.pm * tstepA : cA; const char* nB = has_next ? (const char*)g.Bt + (size_t)nxt.pn * tstep : cB;
        for (int t = 0; t < nt; t += 2) {
            const bool last = (t == nt - 2);
            const char* a1 = cA + (size_t)(t + 1) * kstep;
            const char* a2 = last ? nA : cA + (size_t)(t + 2) * kstep; const char* b2 = last ? nB : cB + (size_t)(t + 2) * kstep;
            const char* a3 = a2 + kstep; const char* b3 = b2 + kstep;
            PG8_LDB(B0, 0, 0); PG8_SCHED; PG8_LDA(At, 0, 0); PG8_STAGE(PG8_SA(1, 1), a1 + hstepA, voffA);
            PG8_WAIT_L(8); PG8_BAR; PG8_WAIT_L(0); if (HSEL != 2) PG8_MMA(0, 0, At, B0); else PG8_KEEPA(At); PG8_BAR; PG8_SCHED;
            PG8_LDB(B1, 0, 1); PG8_STAGE(PG8_SB(0, 0), b2, voffB);
            PG8_BAR; PG8_WAIT_L(0); if (HSEL != 2) PG8_MMA(0, 1, At, B1); else PG8_KEEPA(At); PG8_BAR;
            PG8_LDA(At, 0, 1); PG8_STAGE(PG8_SA(0, 0), a2, voffA);
            PG8_BAR; PG8_WAIT_L(0); if (HSEL != 1) PG8_MMA(1, 0, At, B0); else PG8_KEEPA(At); PG8_BAR; PG8_SCHED;
            PG8_STAGE(PG8_SB(0, 1), b2 + hstep, voffB);
            PG8_WAIT_V(6); PG8_BAR; if (HSEL != 1) PG8_MMA(1, 1, At, B1); else PG8_KEEPA(At); PG8_BAR;
            PG8_LDB(B0, 1, 0); PG8_SCHED; PG8_LDA(At, 1, 0); PG8_STAGE(PG8_SA(0, 1), a2 + hstepA, voffA);
            PG8_WAIT_L(8); PG8_BAR; PG8_WAIT_L(0); if (HSEL != 2) PG8_MMA(0, 0, At, B0); else PG8_KEEPA(At); PG8_BAR; PG8_SCHED;
            PG8_LDB(B1, 1, 1); PG8_STAGE(PG8_SB(1, 0), b3, voffB);
            PG8_BAR; PG8_WAIT_L(0); if (HSEL != 2) PG8_MMA(0, 1, At, B1); else PG8_KEEPA(At); PG8_BAR;
            PG8_LDA(At, 1, 1); PG8_STAGE(PG8_SA(1, 0), a3, voffA);
            PG8_BAR; PG8_WAIT_L(0); if (HSEL != 1) PG8_MMA(1, 0, At, B0); else PG8_KEEPA(At); PG8_BAR; PG8_SCHED;
            PG8_STAGE(PG8_SB(1, 1), b3 + hstep, voffB);
            PG8_WAIT_V(6); PG8_BAR; if (HSEL != 1) PG8_MMA(1, 1, At, B1); else PG8_KEEPA(At); PG8_BAR;
        }
        if constexpr (!Epi::AFTER_DRAIN) E(acc, cur, wr, wc, fr, fq, HSEL);
        if (!has_next) break;
#pragma unroll
        for (int a = 0; a < 2; ++a)
#pragma unroll
            for (int b = 0; b < 2; ++b)
#pragma unroll
                for (int m = 0; m < 4; ++m)
#pragma unroll
                    for (int n = 0; n < 2; ++n) acc[a][b][m][n] = (f32x4){0.f, 0.f, 0.f, 0.f};
        cur = nxt; cA = nA; cB = nB; ++ui;
    }
    PG8_WAIT_V(0);
    if (wr == 0) PG8_BAR;
    PG8_BAR;
    if constexpr (Epi::AFTER_DRAIN) E.fused(acc, cur, wr, wc, fr, fq, lds, wid, lane);
#undef PG8_SA
#undef PG8_SB
#undef PG8_STAGE
#undef PG8_LDA
#undef PG8_LDB
#undef PG8_MMA
#undef PG8_KEEPA
#undef PG8_WAIT_V
#undef PG8_WAIT_L
#undef PG8_BAR
#undef PG8_SCHED
}
}
using pg8::Unit;

__device__ __forceinline__ float silu_f(float g) { return g * __builtin_amdgcn_rcpf(1.0f + __expf(-g)); }

struct EpiSwiGLU {
    static constexpr bool PERM = true, AFTER_DRAIN = false;
    bf16_t* O;
    __device__ __forceinline__ void operator()(const f32x4 (&acc)[2][2][4][2], const Unit& u, int wr, int wc, int fr, int fq, int half) const {
        const int row0 = u.pm * 256 + wr * 64 + fr, col0 = u.pn * 128 + wc * 32 + 8 * fq;
#pragma unroll
        for (int ai = 0; ai < 2; ++ai) {
            if (half == 2 - ai) continue;
#pragma unroll
            for (int m = 0; m < 4; ++m) {
                bf16_t* rowp = O + (size_t)(row0 + ai * 128 + m * 16) * DFF + col0;
                const f32x4 g0 = acc[ai][0][m][0], g1 = acc[ai][0][m][1], u0 = acc[ai][1][m][0], u1 = acc[ai][1][m][1];
                u32x4 w;
                w.x = cvt_pk_bf16(silu_f(g0[0]) * u0[0], silu_f(g0[1]) * u0[1]); w.y = cvt_pk_bf16(silu_f(g0[2]) * u0[2], silu_f(g0[3]) * u0[3]);
                w.z = cvt_pk_bf16(silu_f(g1[0]) * u1[0], silu_f(g1[1]) * u1[1]); w.w = cvt_pk_bf16(silu_f(g1[2]) * u1[2], silu_f(g1[3]) * u1[3]);
                store_wt16(rowp, w);
            }
        }
    }
};
struct EpiResid {
    static constexpr bool PERM = false, AFTER_DRAIN = false;
    const float* base_x; float* out_x; float scale;
    __device__ __forceinline__ void operator()(const f32x4 (&acc)[2][2][4][2], const Unit& u, int wr, int wc, int fr, int fq, int half) const {
        const int col0 = u.pn * 256 + wc * 32 + 4 * fq;
        const int row0 = u.pm * 256 + wr * 64 + fr;
#pragma unroll
        for (int ai = 0; ai < 2; ++ai) {
            if (half == 2 - ai) continue;
#pragma unroll
            for (int m = 0; m < 4; ++m) {
                const size_t off = (size_t)(row0 + ai * 128 + m * 16) * D + col0;
#pragma unroll
                for (int bj = 0; bj < 2; ++bj)
#pragma unroll
                    for (int n = 0; n < 2; ++n) {
                        const f32x4 b = *(const f32x4*)(base_x + off + bj * 128 + n * 16);
                        *(f32x4*)(out_x + off + bj * 128 + n * 16) = b + scale * acc[ai][bj][m][n];
                    }
            }
        }
    }
};
__device__ __forceinline__ bf16_t* hb_ptr(float* out, int r, int c) { return (bf16_t*)out + ((size_t)(r >> 8) * (256 * 1024 * 2) + (size_t)(r & 255) * 1024 + c); }
template <bool HALFS, bool FINAL, bool BASEF32> struct EpiResidNorm {
    static constexpr bool PERM = true, AFTER_DRAIN = true;
    const float* base_x; float* out_x; bf16_t* hn; const float* gain; float* xbuf; unsigned* cnt;
    __device__ __forceinline__ void fused(f32x4 (&acc)[2][2][4][2], const Unit& u, int wr, int wc, int fr, int fq, LAS unsigned char* lds, int wid, int lane) const {
        constexpr float scale = HALFS ? 0.5f : 1.0f;
        LAS float* P = (LAS float*)lds;
        LAS float* S = (LAS float*)(lds + 4096);
        const int col0 = u.pn * 256 + wc * 32 + 8 * fq, rt0 = wr * 64 + fr, tid = wid * 64 + lane;
#pragma unroll
        for (int ai = 0; ai < 2; ++ai)
#pragma unroll
            for (int m = 0; m < 4; ++m) {
                const int rt = rt0 + ai * 128 + m * 16, r = u.pm * 256 + rt;
                float ss = 0.f;
#pragma unroll
                for (int bj = 0; bj < 2; ++bj) {
                    f32x4 b0, b1;
                    if (BASEF32) { const float* bp = base_x + (size_t)r * D + col0 + bj * 128; b0 = __builtin_nontemporal_load((const f32x4*)bp); b1 = __builtin_nontemporal_load((const f32x4*)(bp + 4)); }
                    else { const u32x4 w = *(const u32x4*)hb_ptr(out_x, r, col0 + bj * 128); b0 = (f32x4){bflo(w.x), bfhi(w.x), bflo(w.y), bfhi(w.y)}; b1 = (f32x4){bflo(w.z), bfhi(w.z), bflo(w.w), bfhi(w.w)}; }
                    const f32x4 v0 = b0 + scale * acc[ai][bj][m][0], v1 = b1 + scale * acc[ai][bj][m][1];
                    acc[ai][bj][m][0] = v0; acc[ai][bj][m][1] = v1;
                    ss += (v0[0] * v0[0] + v0[1] * v0[1] + v0[2] * v0[2] + v0[3] * v0[3]) + (v1[0] * v1[0] + v1[1] * v1[1] + v1[2] * v1[2] + v1[3] * v1[3]);
                }
                ss += __shfl_xor(ss, 16); ss += __shfl_xor(ss, 32);
                if (fq == 0) P[rt * 4 + wc] = ss;
                if (BASEF32) asm volatile("" ::: "memory");
            }
        asm volatile("s_waitcnt lgkmcnt(0)" ::: "memory"); __builtin_amdgcn_s_barrier(); asm volatile("" ::: "memory");
        if (tid < 256) {
            const f32x4 q = *(const LAS f32x4*)(P + tid * 4);
            __hip_atomic_store(xbuf + ((size_t)u.pm * 256 + tid) * 4 + u.pn, (q[0] + q[1]) + (q[2] + q[3]), __ATOMIC_RELAXED, __HIP_MEMORY_SCOPE_AGENT);
        }
        asm volatile("s_waitcnt vmcnt(0)" ::: "memory");
        if (tid < 256 && lane == 0) __hip_atomic_fetch_add(cnt + 64 * u.pm, 1u, __ATOMIC_RELAXED, __HIP_MEMORY_SCOPE_AGENT);
        if (wid == 0) {
            unsigned sp = 0;
            while ((unsigned)__builtin_amdgcn_readfirstlane(__hip_atomic_load(cnt + 64 * u.pm, __ATOMIC_RELAXED, __HIP_MEMORY_SCOPE_AGENT)) < 16u) { __builtin_amdgcn_s_sleep(2); if (++sp > (1u << 20)) break; }
            __builtin_amdgcn_fence(__ATOMIC_ACQUIRE, "agent");
            asm volatile("s_waitcnt vmcnt(0)" ::: "memory");
        }
        asm volatile("s_waitcnt vmcnt(0) lgkmcnt(0)" ::: "memory"); __builtin_amdgcn_s_barrier(); asm volatile("" ::: "memory");
        if (tid < 256) {
            const float* slot = xbuf + ((size_t)u.pm * 256 + tid) * 4;
            const float a = __hip_atomic_load(slot + 0, __ATOMIC_RELAXED, __HIP_MEMORY_SCOPE_AGENT), b = __hip_atomic_load(slot + 1, __ATOMIC_RELAXED, __HIP_MEMORY_SCOPE_AGENT);
            const float c = __hip_atomic_load(slot + 2, __ATOMIC_RELAXED, __HIP_MEMORY_SCOPE_AGENT), d = __hip_atomic_load(slot + 3, __ATOMIC_RELAXED, __HIP_MEMORY_SCOPE_AGENT);
            S[tid] = rsqrtf(((a + b) + (c + d)) * (1.0f / D) + RMS_EPS);
        }
        asm volatile("s_waitcnt lgkmcnt(0)" ::: "memory"); __builtin_amdgcn_s_barrier(); asm volatile("" ::: "memory");
        f32x4 g[2][2];
#pragma unroll
        for (int bj = 0; bj < 2; ++bj)
#pragma unroll
            for (int n = 0; n < 2; ++n) g[bj][n] = *(const f32x4*)(gain + col0 + bj * 128 + n * 4);
#pragma unroll
        for (int ai = 0; ai < 2; ++ai)
#pragma unroll
            for (int m = 0; m < 4; ++m) {
                const int rt = rt0 + ai * 128 + m * 16;
                const size_t off = (size_t)(u.pm * 256 + rt) * D + col0;
                const float rs = S[rt];
#pragma unroll
                for (int bj = 0; bj < 2; ++bj) {
                    const f32x4 y0 = acc[ai][bj][m][0] * rs * g[bj][0], y1 = acc[ai][bj][m][1] * rs * g[bj][1];
                    if (FINAL) { __builtin_nontemporal_store(y0, (f32x4*)(out_x + off + bj * 128)); __builtin_nontemporal_store(y1, (f32x4*)(out_x + off + bj * 128 + 4)); }
                    else { u32x4 w; w.x = cvt_pk_bf16(y0[0], y0[1]); w.y = cvt_pk_bf16(y0[2], y0[3]); w.z = cvt_pk_bf16(y1[0], y1[1]); w.w = cvt_pk_bf16(y1[2], y1[3]); store_wt16(hn + off + bj * 128, w);
                           const f32x4 v0 = acc[ai][bj][m][0], v1 = acc[ai][bj][m][1];
                           u32x4 hw; hw.x = cvt_pk_bf16(v0[0], v0[1]); hw.y = cvt_pk_bf16(v0[2], v0[3]); hw.z = cvt_pk_bf16(v1[0], v1[1]); hw.w = cvt_pk_bf16(v1[2], v1[3]); store_wt16(hb_ptr(out_x, u.pm * 256 + rt, col0 + bj * 128), hw); }
                }
                asm volatile("" ::: "memory");
            }
    }
};
template <class Dst> struct EpiBf16T {
    static constexpr bool PERM = true, AFTER_DRAIN = false;
    Dst dst;
    __device__ __forceinline__ void operator()(const f32x4 (&acc)[2][2][4][2], const Unit& u, int wr, int wc, int fr, int fq, int half) const {
        const int row0 = u.pm * 256 + wr * 64 + fr, cw = wc * 32 + 8 * fq;
#pragma unroll
        for (int ai = 0; ai < 2; ++ai) {
            if (half == 2 - ai) continue;
#pragma unroll
            for (int m = 0; m < 4; ++m) {
                const int r = row0 + ai * 128 + m * 16;
#pragma unroll
                for (int bj = 0; bj < 2; ++bj) {
                    const f32x4 v0 = acc[ai][bj][m][0], v1 = acc[ai][bj][m][1];
                    u32x4 w; w.x = cvt_pk_bf16(v0[0], v0[1]); w.y = cvt_pk_bf16(v0[2], v0[3]); w.z = cvt_pk_bf16(v1[0], v1[1]); w.w = cvt_pk_bf16(v1[2], v1[3]);
                    store_wt16(dst(r, u.pn, bj, cw), w);
                }
            }
        }
    }
};
constexpr int NTOK = 16 + SEQ;
struct DstDaQK { bf16_t* Qd; bf16_t* Kh;
    __device__ __forceinline__ bf16_t* operator()(int r, int pn, int bj, int cw) const {
        if (pn < 4) return Qd + (size_t)r * 1024 + pn * 256 + bj * 128 + cw;
        const int b = r >> 11, s = r & 2047, h = 2 * (pn - 4) + bj;
        return Kh + ((size_t)(b * 8 + h) * NTOK + 16 + s) * 128 + cw; } };
struct DstGlaMain { bf16_t* qh; bf16_t* g2;
    __device__ __forceinline__ bf16_t* operator()(int r, int pn, int bj, int cw) const {
        if (pn >= 2) return g2 + (size_t)r * 1536 + (pn - 2) * 256 + bj * 128 + cw;
        const int b = r >> 11, s = r & 2047, h = 2 * pn + bj;
        return qh + ((size_t)(b * 4 + h) * NTOK + 16 + s) * 128 + cw; } };
struct DstVTc { bf16_t* vtc;
    __device__ __forceinline__ bf16_t* operator()(int f, int pn, int bj, int cw) const {
        const int tok = pn * 256 + bj * 128 + cw, b = tok >> 11, s = tok & 2047;
        return vtc + ((size_t)(b * 33 + 1 + (s >> 6)) * 1024 + f) * 64 + (s & 63); } };
struct Job { const float* src; bf16_t* dst; int ldw, K, ndst, col0, mode, nvalid, tile0, pad; };
struct Params {
    const float *x, *meta, *ffn1_norm, *mix_norm, *ffn2_norm, *da_lambda, *da_subln, *gla_w_gate2, *gla_b_gate2, *gla_norm, *final_norm;
    float* out;
    bf16_t* w_ffn_in[4]; bf16_t* w_ffn_out[4];
    bf16_t *w_da_qk, *w_da_v, *w_da_out, *w_gla_main, *w_gla_v, *w_gla_out;
    bf16_t *big, *hn, *kdecT;
    bf16_t *qd, *kh, *vtc_da, *g2, *qh, *vtc_gla;
    float *hmeta, *glr, *decay;
    unsigned* bar; unsigned* xcnt; float* xbuf;
    Job jobs[16];
    int njobs, ntiles_prep, ph_lo, ph_hi;
};

__device__ __forceinline__ void prep_phase(const Params& p, unsigned char* shm) {
    float* tile = (float*)shm;
    const int tid = threadIdx.x;
    const int n4 = (tid & 31) * 4, kk0 = tid >> 5;
#define PREP_FETCH(T, V, DST, KK, K0, N0, VALID) do { \
        int j_ = 0; for (int q = 1; q < p.njobs; ++q) if ((T) >= p.jobs[q].tile0) j_ = q; \
        const Job jb = p.jobs[j_]; \
        const int lt = (T) - jb.tile0, nkt = jb.K / 128, kt = lt % nkt, ntile = lt / nkt; \
        K0 = kt * 128; N0 = ntile * 128; KK = jb.K; DST = jb.dst; \
        int scol; if (jb.mode == 1) { const int pn = N0 >> 8, bj = (N0 >> 7) & 1; scol = bj * DFF + 128 * pn; } else scol = jb.col0 + N0; \
        VALID = N0 < jb.nvalid; \
        if (VALID) { \
            _Pragma("unroll") for (int i = 0; i < 8; ++i) { \
                const float* s = jb.src + (size_t)(K0 + kk0 + 16 * i) * jb.ldw + scol + n4; \
                if (N0 + n4 + 3 < jb.nvalid) V[i] = __builtin_nontemporal_load((const f32x4*)s);     \
                else { for (int q = 0; q < 4; ++q) V[i][q] = (N0 + n4 + q < jb.nvalid) ? s[q] : 0.f; } } } } while (0)
    f32x4 v[8], vn[8];
    bf16_t* dstc = nullptr; bf16_t* dstn = nullptr; int Kc = 0, k0c = 0, n0c = 0, Kn = 0, k0n = 0, n0n = 0; bool validc = false, validn = false;
    int t = blockIdx.x;
    if (t < p.ntiles_prep) PREP_FETCH(t, v, dstc, Kc, k0c, n0c, validc);
    for (; t < p.ntiles_prep; t += gridDim.x) {
        const int tn = t + gridDim.x;
        if (tn < p.ntiles_prep) PREP_FETCH(tn, vn, dstn, Kn, k0n, n0n, validn);
        __syncthreads();
        if (validc) {
#pragma unroll
            for (int i = 0; i < 8; ++i) { float* tp = tile + (kk0 + 16 * i) * 129 + n4; tp[0] = v[i][0]; tp[1] = v[i][1]; tp[2] = v[i][2]; tp[3] = v[i][3]; }
        }
        __syncthreads();
        const int nn = (tid & 31) + 32 * ((tid >> 6) & 3), ks = ((tid >> 5) & 1) + 2 * (tid >> 8);
        bf16_t* dp = dstc + (size_t)(n0c + nn) * Kc + k0c + ks * 32;
#pragma unroll
        for (int q4 = 0; q4 < 4; ++q4) {
            u32x4 w = (u32x4){0u, 0u, 0u, 0u};
            if (validc) {
                float x[8];
#pragma unroll
                for (int q = 0; q < 8; ++q) x[q] = tile[(ks * 32 + q4 * 8 + q) * 129 + nn];
                w.x = cvt_pk_bf16(x[0], x[1]); w.y = cvt_pk_bf16(x[2], x[3]); w.z = cvt_pk_bf16(x[4], x[5]); w.w = cvt_pk_bf16(x[6], x[7]);
            }
            *(u32x4*)(dp + q4 * 8) = w;
        }
#pragma unroll
        for (int i = 0; i < 8; ++i) v[i] = vn[i];
        dstc = dstn; Kc = Kn; k0c = k0n; n0c = n0n; validc = validn;
    }
#undef PREP_FETCH
    for (int i = blockIdx.x * 512 + tid; i < XCNT_WORDS; i += gridDim.x * 512) p.xcnt[i] = 0u;
    for (int i = blockIdx.x * 512 + tid; i < MMETA * D / 4; i += gridDim.x * 512) {
        const int row = i / (D / 4), c4 = i % (D / 4);
        ((f32x4*)p.hmeta)[i] = ((const f32x4*)p.meta)[(row & 15) * (D / 4) + c4];
    }
}

__device__ __forceinline__ void norm_phase(const Params& p, const float* srcx, const float* gain, bool final_out, bool first = false) {
    const int wid = threadIdx.x >> 6, lane = threadIdx.x & 63;
    const int nrows = final_out ? MX : MTOT, stride = gridDim.x * 8;
    f32x4 g[4];
#pragma unroll
    for (int i = 0; i < 4; ++i) g[i] = *(const f32x4*)(gain + i * 256 + lane * 4);
    auto rowsrc = [&](int row) { return row < MX ? srcx + (size_t)row * D : (first ? p.meta + (size_t)((row - MX) & 15) * D : p.hmeta + (size_t)(row - MX) * D); };
    int row = blockIdx.x * 8 + wid;
    f32x4 v[4], vn[4];
    if (row < nrows) { const float* src = rowsrc(row);
#pragma unroll
        for (int i = 0; i < 4; ++i) v[i] = first ? __builtin_nontemporal_load((const f32x4*)(src + i * 256 + lane * 4)) : *(const f32x4*)(src + i * 256 + lane * 4); }
    for (; row < nrows; row += stride) {
        const int nrow = row + stride;
        if (nrow < nrows) { const float* src = rowsrc(nrow);
#pragma unroll
            for (int i = 0; i < 4; ++i) vn[i] = first ? __builtin_nontemporal_load((const f32x4*)(src + i * 256 + lane * 4)) : *(const f32x4*)(src + i * 256 + lane * 4); }
        float ss = 0.f;
#pragma unroll
        for (int i = 0; i < 4; ++i) ss += v[i][0] * v[i][0] + v[i][1] * v[i][1] + v[i][2] * v[i][2] + v[i][3] * v[i][3];
#pragma unroll
        for (int o = 32; o >= 1; o >>= 1) ss += __shfl_xor(ss, o);
        const float rstd = rsqrtf(ss * (1.0f / D) + RMS_EPS);
        if (final_out) {
            float* dst = p.out + (size_t)row * D;
#pragma unroll
            for (int i = 0; i < 4; ++i) *(f32x4*)(dst + i * 256 + lane * 4) = v[i] * rstd * g[i];
        } else {
            bf16_t* dst = p.hn + (size_t)row * D;
#pragma unroll
            for (int i = 0; i < 4; ++i) { const f32x4 y = v[i] * rstd * g[i]; u32x2 w; w.x = cvt_pk_bf16(y[0], y[1]); w.y = cvt_pk_bf16(y[2], y[3]); *(u32x2*)(dst + i * 256 + lane * 4) = w; }
        }
#pragma unroll
        for (int i = 0; i < 4; ++i) v[i] = vn[i];
    }
}

__device__ __forceinline__ void attn_phase(const Params& p, unsigned char* shm) {
    const int tid = threadIdx.x, wid = tid >> 6, lane = tid & 63, fr = lane & 15, fq = lane >> 4;
    const int qi = wid & 3, mp = wid >> 2;
    bf16_t* Ksb = (bf16_t*)shm;
    bf16_t* Vsb = (bf16_t*)(shm + 2 * 17408);
    float* Xs = (float*)shm;
    float lam;
    { float s0 = 0.f, s1 = 0.f; for (int d = 0; d < 64; ++d) { s0 += p.da_lambda[d] * p.da_lambda[64 + d]; s1 += p.da_lambda[128 + d] * p.da_lambda[192 + d]; }
      lam = __expf(s0) - __expf(s1) + 0.2f; }
    const float lam_init = 0.2f;
    const float sc2 = 0.125f * 1.44269504089f;
    const int kr0 = tid >> 4, kc0 = (tid & 15) * 8, vr0 = tid >> 3, vc0 = (tid & 7) * 8;
    const int kp0 = 16 * ((kr0 >> 2) & 1) + 4 * (kr0 >> 3) + (kr0 & 3);
    for (int v = blockIdx.x; v < 256; v += gridDim.x) {
        const int xcd = v & 7, slot = v >> 3, bh = xcd * 8 + (slot >> 2), jj = slot & 3, b = bh >> 3, h = bh & 7;
        const int nitems = (jj == 0) ? 5 : 4;
        const bf16_t* kbase = p.kh + ((size_t)(b * 8 + h) * NTOK + kr0) * 128 + kc0;
        const bf16_t* vbase = p.vtc_da + ((size_t)(b * 33) * 1024 + h * 128 + vr0) * 64 + vc0;
        for (int it = 0; it < nitems; ++it) {
            const bool meta = (it == 4);
            const int pp = meta ? 0 : ((it & 1) ? (8 * (it >> 1) + 7 - jj) : (8 * (it >> 1) + jj));
            const int ntiles = meta ? 1 : 2 * pp + 3;
            const int qrowA = (meta ? MX + b * 16 : b * SEQ + 128 * pp) + 16 * qi + fr;
            const int qrowB = meta ? qrowA : qrowA + 64;
            u32x4 kreg[2], vreg[2];
            { kreg[0] = *(const u32x4*)(kbase); kreg[1] = *(const u32x4*)(kbase + 32 * 128);
              vreg[0] = *(const u32x4*)(vbase); vreg[1] = *(const u32x4*)(vbase + 64 * 64); }
            bf16x8 Qf[2][2];
#pragma unroll
            for (int kd = 0; kd < 2; ++kd) { Qf[0][kd] = *(const bf16x8*)(p.qd + (size_t)qrowA * 1024 + h * 128 + mp * 64 + kd * 32 + fq * 8);
                                             Qf[1][kd] = *(const bf16x8*)(p.qd + (size_t)qrowB * 1024 + h * 128 + mp * 64 + kd * 32 + fq * 8); }
            f32x4 accO[2][8];
#pragma unroll
            for (int blk = 0; blk < 2; ++blk)
#pragma unroll
                for (int nb = 0; nb < 8; ++nb) accO[blk][nb] = (f32x4){0.f, 0.f, 0.f, 0.f};
            float mrun[2] = {-INFINITY, -INFINITY}, lrun[2] = {0.f, 0.f};
            __syncthreads();
            *(u32x4*)(Ksb + kp0 * 136 + kc0) = kreg[0]; *(u32x4*)(Ksb + (kp0 + 32) * 136 + kc0) = kreg[1];
            *(u32x4*)(Vsb + vr0 * 72 + vc0) = vreg[0]; *(u32x4*)(Vsb + (vr0 + 64) * 72 + vc0) = vreg[1];
            __syncthreads();
            for (int t = 0; t < ntiles; ++t) {
                const bf16_t* Ks = Ksb + (t & 1) * (64 * 136);
                const bf16_t* Vs = Vsb + (t & 1) * (128 * 72);
                if (t + 1 < ntiles) {
                    const bf16_t* kp = kbase + (size_t)(16 + 64 * t) * 128; const bf16_t* vp = vbase + (size_t)(t + 1) * 65536;
                    kreg[0] = *(const u32x4*)(kp); kreg[1] = *(const u32x4*)(kp + 32 * 128);
                    vreg[0] = *(const u32x4*)(vp); vreg[1] = *(const u32x4*)(vp + 64 * 64);
                }
                const bool actA = meta || (t + 1 < ntiles);
                f32x4 s[2][2][2];
                __builtin_amdgcn_s_setprio(1);
#pragma unroll
                for (int ks = 0; ks < 2; ++ks)
#pragma unroll
                    for (int a = 0; a < 2; ++a) {
                        f32x4 zA = (f32x4){0.f, 0.f, 0.f, 0.f}, zB = (f32x4){0.f, 0.f, 0.f, 0.f};
#pragma unroll
                        for (int kd = 0; kd < 2; ++kd) { const bf16x8 kf = *(const bf16x8*)(Ks + (32 * ks + 16 * a + fr) * 136 + mp * 64 + kd * 32 + fq * 8);
                            zA = __builtin_amdgcn_mfma_f32_16x16x32_bf16(kf, Qf[0][kd], zA, 0, 0, 0); zB = __builtin_amdgcn_mfma_f32_16x16x32_bf16(kf, Qf[1][kd], zB, 0, 0, 0); }
                        s[0][ks][a] = zA; s[1][ks][a] = zB;
                    }
                __builtin_amdgcn_s_setprio(0);
                if (t == 0) {
#pragma unroll
                    for (int blk = 0; blk < 2; ++blk)
#pragma unroll
                        for (int ks = 0; ks < 2; ++ks)
#pragma unroll
                            for (int a = 0; a < 2; ++a)
#pragma unroll
                                for (int j = 0; j < 4; ++j) if (32 * ks + 8 * fq + 4 * a + j >= 16) s[blk][ks][a][j] = -INFINITY;
                }
                bf16x8 Pf[2][2]; float alpha[2];
#pragma unroll
                for (int blk = 0; blk < 2; ++blk) {
                    float tm = -INFINITY;
#pragma unroll
                    for (int ks = 0; ks < 2; ++ks)
#pragma unroll
                        for (int a = 0; a < 2; ++a)
#pragma unroll
                            for (int j = 0; j < 4; ++j) tm = fmaxf(tm, s[blk][ks][a][j]);
                    tm = fmaxf(tm, __shfl_xor(tm, 16)); tm = fmaxf(tm, __shfl_xor(tm, 32));
                    const float mnew = fmaxf(mrun[blk], tm * sc2);
                    alpha[blk] = __builtin_amdgcn_exp2f(mrun[blk] - mnew);
                    float ps = 0.f;
#pragma unroll
                    for (int ks = 0; ks < 2; ++ks) {
                        float e[8];
#pragma unroll
                        for (int a = 0; a < 2; ++a)
#pragma unroll
                            for (int j = 0; j < 4; ++j) { e[4 * a + j] = __builtin_amdgcn_exp2f(__builtin_fmaf(s[blk][ks][a][j], sc2, -mnew)); ps += e[4 * a + j]; }
                        u32x4 w; w.x = cvt_pk_bf16(e[0], e[1]); w.y = cvt_pk_bf16(e[2], e[3]); w.z = cvt_pk_bf16(e[4], e[5]); w.w = cvt_pk_bf16(e[6], e[7]);
                        Pf[blk][ks] = __builtin_bit_cast(bf16x8, w);
                    }
                    if (blk == 1 || actA) { mrun[blk] = mnew; lrun[blk] = lrun[blk] * alpha[blk] + ps; }
                }
                __builtin_amdgcn_s_setprio(1);
                if (actA) {
#pragma unroll
                    for (int nb = 0; nb < 8; ++nb) {
                        f32x4 oA = accO[0][nb] * alpha[0], oB = accO[1][nb] * alpha[1];
#pragma unroll
                        for (int ks = 0; ks < 2; ++ks) { const bf16x8 vf = *(const bf16x8*)(Vs + (nb * 16 + fr) * 72 + ks * 32 + fq * 8);
                            oA = __builtin_amdgcn_mfma_f32_16x16x32_bf16(vf, Pf[0][ks], oA, 0, 0, 0); oB = __builtin_amdgcn_mfma_f32_16x16x32_bf16(vf, Pf[1][ks], oB, 0, 0, 0); }
                        accO[0][nb] = oA; accO[1][nb] = oB;
                    }
                } else {
#pragma unroll
                    for (int nb = 0; nb < 8; ++nb) {
                        f32x4 oB = accO[1][nb] * alpha[1];
#pragma unroll
                        for (int ks = 0; ks < 2; ++ks) { const bf16x8 vf = *(const bf16x8*)(Vs + (nb * 16 + fr) * 72 + ks * 32 + fq * 8); oB = __builtin_amdgcn_mfma_f32_16x16x32_bf16(vf, Pf[1][ks], oB, 0, 0, 0); }
                        accO[1][nb] = oB;
                    }
                }
                __builtin_amdgcn_s_setprio(0);
                if (t + 1 < ntiles) {
                    bf16_t* Kn = Ksb + ((t + 1) & 1) * (64 * 136); bf16_t* Vn = Vsb + ((t + 1) & 1) * (128 * 72);
                    *(u32x4*)(Kn + kp0 * 136 + kc0) = kreg[0]; *(u32x4*)(Kn + (kp0 + 32) * 136 + kc0) = kreg[1];
                    *(u32x4*)(Vn + vr0 * 72 + vc0) = vreg[0]; *(u32x4*)(Vn + (vr0 + 64) * 72 + vc0) = vreg[1];
                }
                __syncthreads();
            }
            float inv[2];
#pragma unroll
            for (int blk = 0; blk < 2; ++blk) { float l = lrun[blk]; l += __shfl_xor(l, 16); l += __shfl_xor(l, 32); inv[blk] = 1.0f / l; }
            if (mp == 1) {
#pragma unroll
                for (int blk = 0; blk < 2; ++blk)
#pragma unroll
                    for (int nb = 0; nb < 8; ++nb) *(f32x4*)(Xs + ((blk * 4 + qi) * 16 + fr) * 132 + nb * 16 + fq * 4) = accO[blk][nb] * inv[blk];
            }
            __syncthreads();
            if (mp == 0) {
#pragma unroll
                for (int blk = 0; blk < 2; ++blk) {
                    if (meta && (blk == 1 || qi != 0)) continue;
                    float ss = 0.f;
#pragma unroll
                    for (int nb = 0; nb < 8; ++nb) { const f32x4 o2 = *(const f32x4*)(Xs + ((blk * 4 + qi) * 16 + fr) * 132 + nb * 16 + fq * 4); const f32x4 o = accO[blk][nb] * inv[blk] - lam * o2; accO[blk][nb] = o; ss += o[0] * o[0] + o[1] * o[1] + o[2] * o[2] + o[3] * o[3]; }
                    ss += __shfl_xor(ss, 16); ss += __shfl_xor(ss, 32);
                    const float rs = rsqrtf(ss * (1.0f / 128.0f) + RMS_EPS) * (1.0f - lam_init);
                    bf16_t* dst = p.qd + (size_t)(blk ? qrowB : qrowA) * D + h * 128 + fq * 4;
#pragma unroll
                    for (int nb = 0; nb < 8; ++nb) { const f32x4 gg = *(const f32x4*)(p.da_subln + nb * 16 + fq * 4); const f32x4 y = accO[blk][nb] * rs * gg;
                        u32x2 w; w.x = cvt_pk_bf16(y[0], y[1]); w.y = cvt_pk_bf16(y[2], y[3]); *(u32x2*)(dst + nb * 16) = w; }
                }
            }
        }
    }
}

__device__ __forceinline__ void gla_prep_phase(const Params& p, unsigned char* shm) {
    float* gl = (float*)shm;
    bf16_t* kt = (bf16_t*)(shm + 4096);
    const int tid = threadIdx.x;
    float w2[16];
#pragma unroll
    for (int r = 0; r < 16; ++r) w2[r] = p.gla_w_gate2[r * 512 + tid];
    const float bias = p.gla_b_gate2[tid];
    for (int it = blockIdx.x; it < NB * 33; it += gridDim.x) {
        const int b = it < 256 ? (it >> 5) : (it - 256), ch = it < 256 ? 1 + (it & 31) : 0;
        const int item = b * 33 + ch;
        const int row0 = ch == 0 ? MX + b * 16 : b * SEQ + 64 * (ch - 1);
        const int nvalid = ch == 0 ? 16 : 64;
        __syncthreads();
        for (int i = tid; i < 1024; i += 512) gl[i] = p.glr[(size_t)row0 * 16 + i];
        { u32x4 kv[8];
#pragma unroll
          for (int i = 0; i < 8; ++i) { const int ch16 = tid + 512 * i, r = ch16 >> 6, c8 = (ch16 & 63) * 8; const int rr = r < nvalid ? r : nvalid - 1;
              kv[i] = *(const u32x4*)(p.g2 + (size_t)(row0 + rr) * 1536 + c8); }
#pragma unroll
          for (int i = 0; i < 8; ++i) { const int ch16 = tid + 512 * i, r = ch16 >> 6, c8 = (ch16 & 63) * 8; *(u32x4*)(kt + r * 512 + c8) = kv[i]; } }
        __syncthreads();
        float gend = 0.f;
        for (int t = 0; t < nvalid; ++t) {
            float z = bias;
#pragma unroll
            for (int r = 0; r < 16; ++r) z += gl[t * 16 + r] * w2[r];
            gend += (fminf(z, 0.f) - __logf(1.0f + __expf(-fabsf(z)))) * (1.0f / 16.0f);
        }
        p.decay[(size_t)item * 512 + tid] = __expf(gend);
        bf16_t* dst = p.kdecT + ((size_t)item * 512 + tid) * 64;
        float G = 0.f;
        for (int t8 = 0; t8 < 8; ++t8) {
            float kd[8];
#pragma unroll
            for (int q = 0; q < 8; ++q) {
                const int t = t8 * 8 + q;
                float val = 0.f;
                if (t < nvalid) {
                    float z = bias;
#pragma unroll
                    for (int r = 0; r < 16; ++r) z += gl[t * 16 + r] * w2[r];
                    G += (fminf(z, 0.f) - __logf(1.0f + __expf(-fabsf(z)))) * (1.0f / 16.0f);
                    val = bf2f(kt[t * 512 + tid]) * __expf(gend - G);
                }
                kd[q] = val;
            }
            u32x4 w; w.x = cvt_pk_bf16(kd[0], kd[1]); w.y = cvt_pk_bf16(kd[2], kd[3]); w.z = cvt_pk_bf16(kd[4], kd[5]); w.w = cvt_pk_bf16(kd[6], kd[7]);
            *(u32x4*)(dst + t8 * 8) = w;
        }
    }
}

struct ScanOps { bf16x8 Af[2], Bf[2][2], Qf[4]; f32x4 dc; };
__device__ __forceinline__ void scan_load(ScanOps& o, const Params& p, int b, int h, int dvs, int ch, int wid, int fr, int fq) {
    const int item = b * 33 + ch;
    const int tok0 = ch == 0 ? 0 : 16 + 64 * (ch - 1);
    const int tb = wid >> 1;
#pragma unroll
    for (int ks = 0; ks < 2; ++ks) {
        o.Af[ks] = *(const bf16x8*)(p.kdecT + ((size_t)item * 512 + h * 128 + wid * 16 + fr) * 64 + ks * 32 + fq * 8);
#pragma unroll
        for (int vb = 0; vb < 2; ++vb) o.Bf[vb][ks] = *(const bf16x8*)(p.vtc_gla + ((size_t)item * 1024 + h * 256 + dvs * 32 + vb * 16 + fr) * 64 + ks * 32 + fq * 8);
    }
    o.dc = *(const f32x4*)(p.decay + (size_t)item * 512 + h * 128 + wid * 16 + fq * 4);
#pragma unroll
    for (int kc = 0; kc < 4; ++kc) o.Qf[kc] = *(const bf16x8*)(p.qh + ((size_t)(b * 4 + h) * NTOK + tok0 + tb * 16 + fr) * 128 + kc * 32 + fq * 8);
}
__device__ __forceinline__ void gla_scan_phase(const Params& p, unsigned char* shm) {
    const int tid = threadIdx.x, wid = tid >> 6, lane = tid & 63, fr = lane & 15, fq = lane >> 4;
    bf16_t* Ssb = (bf16_t*)shm;
    const float qscale = 0.08838834764831845f;
    for (int wg = blockIdx.x; wg < 256; wg += gridDim.x) {
        const int xcd_ = wg & 7, slot_ = wg >> 3, bh_ = xcd_ * 4 + (slot_ >> 3);
        const int b = bh_ >> 2, h = bh_ & 3, dvs = slot_ & 7;
        f32x4 accS[2] = {(f32x4){0.f, 0.f, 0.f, 0.f}, (f32x4){0.f, 0.f, 0.f, 0.f}};
        const int tb = wid >> 1, vb2 = wid & 1;
        ScanOps r0, r1, r2, r3;
        scan_load(r0, p, b, h, dvs, 0, wid, fr, fq);
        scan_load(r1, p, b, h, dvs, 1, wid, fr, fq);
        scan_load(r2, p, b, h, dvs, 2, wid, fr, fq);
        __syncthreads();
#define SCAN_STEP(CUR, NXT, CH) do { const int ch_ = (CH); \
            const int row0 = ch_ == 0 ? MX + b * 16 : b * SEQ + 64 * (ch_ - 1); const int nvalid = ch_ == 0 ? 16 : 64; \
            bf16_t* Ss = Ssb + (ch_ & 1) * (32 * 136); \
            if (ch_ + 3 < 33) scan_load(NXT, p, b, h, dvs, ch_ + 3, wid, fr, fq); \
            _Pragma("unroll") for (int vb = 0; vb < 2; ++vb) { \
                f32x4 s = accS[vb] * CUR.dc; \
                _Pragma("unroll") for (int ks = 0; ks < 2; ++ks) s = __builtin_amdgcn_mfma_f32_16x16x32_bf16(CUR.Af[ks], CUR.Bf[vb][ks], s, 0, 0, 0); \
                accS[vb] = s; \
                u32x2 w; w.x = cvt_pk_bf16(s[0], s[1]); w.y = cvt_pk_bf16(s[2], s[3]); \
                *(u32x2*)(Ss + (vb * 16 + fr) * 136 + wid * 16 + fq * 4) = w; } \
            asm volatile("s_waitcnt lgkmcnt(0)" ::: "memory"); __builtin_amdgcn_s_barrier(); asm volatile("" ::: "memory");     \
            f32x4 o = (f32x4){0.f, 0.f, 0.f, 0.f}; \
            _Pragma("unroll") for (int kc = 0; kc < 4; ++kc) { const bf16x8 sf = *(const bf16x8*)(Ss + (vb2 * 16 + fr) * 136 + kc * 32 + fq * 8); o = __builtin_amdgcn_mfma_f32_16x16x32_bf16(sf, CUR.Qf[kc], o, 0, 0, 0); } \
            if (tb * 16 + fr < nvalid) { o = o * qscale; u32x2 w; w.x = cvt_pk_bf16(o[0], o[1]); w.y = cvt_pk_bf16(o[2], o[3]); \
                *(u32x2*)(p.hn + (size_t)(row0 + tb * 16 + fr) * D + h * 256 + dvs * 32 + vb2 * 16 + fq * 4) = w; } \
        } while (0)
        for (int c4 = 0; c4 < 32; c4 += 4) {
            SCAN_STEP(r0, r3, c4); SCAN_STEP(r1, r0, c4 + 1); SCAN_STEP(r2, r1, c4 + 2); SCAN_STEP(r3, r2, c4 + 3);
        }
        SCAN_STEP(r0, r3, 32);
#undef SCAN_STEP
        __syncthreads();
    }
}

__device__ __forceinline__ void gla_post_phase(const Params& p) {
    const int wid = threadIdx.x >> 6, lane = threadIdx.x & 63, stride = gridDim.x * 8;
    const f32x4 g = *(const f32x4*)(p.gla_norm + lane * 4);
    int row = blockIdx.x * 8 + wid;
    u32x2 ow[4], gw[4], own[4], gwn[4];
    if (row < MTOT) {
#pragma unroll
        for (int h = 0; h < 4; ++h) { ow[h] = *(const u32x2*)(p.hn + (size_t)row * D + h * 256 + lane * 4); gw[h] = *(const u32x2*)(p.g2 + (size_t)row * 1536 + 512 + h * 256 + lane * 4); } }
    for (; row < MTOT; row += stride) {
        const int nrow = row + stride;
        if (nrow < MTOT) {
#pragma unroll
            for (int h = 0; h < 4; ++h) { own[h] = *(const u32x2*)(p.hn + (size_t)nrow * D + h * 256 + lane * 4); gwn[h] = *(const u32x2*)(p.g2 + (size_t)nrow * 1536 + 512 + h * 256 + lane * 4); } }
#pragma unroll
        for (int h = 0; h < 4; ++h) {
            const float o0 = bflo(ow[h].x), o1 = bfhi(ow[h].x), o2 = bflo(ow[h].y), o3 = bfhi(ow[h].y);
            float ss = o0 * o0 + o1 * o1 + o2 * o2 + o3 * o3;
#pragma unroll
            for (int o = 32; o >= 1; o >>= 1) ss += __shfl_xor(ss, o);
            const float rs = rsqrtf(ss * (1.0f / 256.0f) + RMS_EPS);
            const float y0 = o0 * rs * g[0] * silu_f(bflo(gw[h].x)), y1 = o1 * rs * g[1] * silu_f(bfhi(gw[h].x)), y2 = o2 * rs * g[2] * silu_f(bflo(gw[h].y)), y3 = o3 * rs * g[3] * silu_f(bfhi(gw[h].y));
            u32x2 w; w.x = cvt_pk_bf16(y0, y1); w.y = cvt_pk_bf16(y2, y3);
            *(u32x2*)(p.g2 + (size_t)row * 1536 + 512 + h * 256 + lane * 4) = w;
        }
#pragma unroll
        for (int h = 0; h < 4; ++h) { ow[h] = own[h]; gw[h] = gwn[h]; }
    }
}

template <int NBLK, bool TRANS_OUT, class Fin>
__device__ __forceinline__ void small_gemm_item(unsigned char* shm, const bf16_t* A, int lda, const bf16_t* Bt0, const bf16_t* Bt1, int K, const Fin& fin) {
    const int tid = threadIdx.x, wid = tid >> 6, lane = tid & 63, fr = lane & 15, fq = lane >> 4;
    const int kw = K >> 3, k0 = wid * kw;
    f32x4 acc[8][NBLK];
#pragma unroll
    for (int rb = 0; rb < 8; ++rb)
#pragma unroll
        for (int cb = 0; cb < NBLK; ++cb) acc[rb][cb] = (f32x4){0.f, 0.f, 0.f, 0.f};
    const bf16_t* ap = A + (size_t)fr * lda + k0 + fq * 8;
    const bf16_t* bp0 = Bt0 + (size_t)fr * K + k0 + fq * 8;
    const bf16_t* bp1 = Bt1 + (size_t)fr * K + k0 + fq * 8;
    bf16x8 bf[NBLK], af[8], bfn[NBLK], afn[8];
    bf[0] = *(const bf16x8*)(bp0);
    if (NBLK > 1) bf[NBLK - 1] = *(const bf16x8*)(bp1);
#pragma unroll
    for (int rb = 0; rb < 8; ++rb) af[rb] = *(const bf16x8*)(ap + (size_t)rb * 16 * lda);
#pragma unroll 1
    for (int k = 0; k < kw; k += 32) {
        const int kn = (k + 32 < kw) ? k + 32 : k;
        bfn[0] = *(const bf16x8*)(bp0 + kn);
        if (NBLK > 1) bfn[NBLK - 1] = *(const bf16x8*)(bp1 + kn);
#pragma unroll
        for (int rb = 0; rb < 8; ++rb) afn[rb] = *(const bf16x8*)(ap + (size_t)rb * 16 * lda + kn);
#pragma unroll
        for (int rb = 0; rb < 8; ++rb)
#pragma unroll
            for (int cb = 0; cb < NBLK; ++cb)
                acc[rb][cb] = TRANS_OUT ? __builtin_amdgcn_mfma_f32_16x16x32_bf16(af[rb], bf[cb], acc[rb][cb], 0, 0, 0)
                                        : __builtin_amdgcn_mfma_f32_16x16x32_bf16(bf[cb], af[rb], acc[rb][cb], 0, 0, 0);
#pragma unroll
        for (int cb = 0; cb < NBLK; ++cb) bf[cb] = bfn[cb];
#pragma unroll
        for (int rb = 0; rb < 8; ++rb) af[rb] = afn[rb];
    }
    f32x4* part = (f32x4*)shm;
    __syncthreads();
#pragma unroll
    for (int rb = 0; rb < 8; ++rb)
#pragma unroll
        for (int cb = 0; cb < NBLK; ++cb) part[((wid * 8 + rb) * NBLK + cb) * 64 + lane] = acc[rb][cb];
    __syncthreads();
    f32x4 sum[NBLK];
#pragma unroll
    for (int cb = 0; cb < NBLK; ++cb) {
        f32x4 s = (f32x4){0.f, 0.f, 0.f, 0.f};
#pragma unroll
        for (int w = 0; w < 8; ++w) s += part[((w * 8 + wid) * NBLK + cb) * 64 + lane];
        sum[cb] = s;
    }
    fin(wid, sum, fr, fq);
    __syncthreads();
}
__device__ __forceinline__ u32x2 pack4(const f32x4 v) { u32x2 w; w.x = cvt_pk_bf16(v[0], v[1]); w.y = cvt_pk_bf16(v[2], v[3]); return w; }

#define SMALL_ITEMS(i, n) for (int i = (int)gridDim.x - 1 - (int)blockIdx.x; i < (n); i += (int)gridDim.x)

__device__ __forceinline__ void ph_ffn_in(const Params& p, unsigned char* shm, int widx) {
    const bf16_t* W = p.w_ffn_in[widx];
    SMALL_ITEMS(i, DFF / 16) {
        const int pn = (16 * i) >> 7, within = (16 * i) & 127;
        bf16_t* O = p.big;
        auto fin = [=](int rb, const f32x4 (&s)[2], int fr, int fq) {
            f32x4 y; for (int j = 0; j < 4; ++j) y[j] = silu_f(s[0][j]) * s[1][j];
            *(u32x2*)(O + (size_t)(MX + rb * 16 + fr) * DFF + 16 * i + fq * 4) = pack4(y); };
        small_gemm_item<2, false>(shm, p.hn + (size_t)MX * D, D, W + (size_t)(256 * pn + within) * D, W + (size_t)(256 * pn + 128 + within) * D, D, fin);
    }
    pg8::StaticOrder S; pg8::Gemm g{p.hn, W, MX, 2 * DFF, D, D}; S.init(g.M, g.N, gridDim.x, blockIdx.x);
    EpiSwiGLU E{p.big};
    if (S.split_tail()) {
        S.mode = 1; pg8::gemm_phase((LAS unsigned char*)shm, g, S, E);
        S.mode = 2;
        if (blockIdx.x & 1) pg8::gemm_phase<EpiSwiGLU, 2>((LAS unsigned char*)shm, g, S, E);
        else pg8::gemm_phase<EpiSwiGLU, 1>((LAS unsigned char*)shm, g, S, E);
    } else pg8::gemm_phase((LAS unsigned char*)shm, g, S, E);
}
template <bool HALFS, bool FINAL, bool BASEF32>
__device__ __forceinline__ void ph_resid(const Params& p, unsigned char* shm, const bf16_t* A, int lda, const bf16_t* Bt, int K, const float* base_x, const float* gain, int inst) {
    constexpr float scale = HALFS ? 0.5f : 1.0f;
    if (!FINAL) {
        unsigned* cmeta = p.xcnt + 6 * 64 * 64 + inst * 64;
        SMALL_ITEMS(i, D / 32) {
            float* H = p.hmeta;
            auto fin = [=](int rb, const f32x4 (&s)[2], int fr, int fq) {
#pragma unroll
                for (int cb = 0; cb < 2; ++cb) { float* hp = H + (size_t)(rb * 16 + fr) * D + 32 * i + cb * 16 + fq * 4; *(f32x4*)hp = *(const f32x4*)hp + scale * s[cb]; } };
            small_gemm_item<2, false>(shm, A + (size_t)MX * lda, lda, Bt + (size_t)(32 * i) * K, Bt + (size_t)(32 * i + 16) * K, K, fin);
            asm volatile("s_waitcnt vmcnt(0)" ::: "memory");
            __syncthreads();
            LAS unsigned* flag = (LAS unsigned*)shm;
            if (threadIdx.x == 0) {
                __builtin_amdgcn_fence(__ATOMIC_RELEASE, "agent");
                asm volatile("s_waitcnt vmcnt(0)" ::: "memory");
                const unsigned old = __hip_atomic_fetch_add(cmeta, 1u, __ATOMIC_RELAXED, __HIP_MEMORY_SCOPE_AGENT);
                const unsigned last = (old == (unsigned)(D / 32 - 1)) ? 1u : 0u;
                if (last) { __builtin_amdgcn_fence(__ATOMIC_ACQUIRE, "agent"); asm volatile("s_waitcnt vmcnt(0)" ::: "memory"); }
                *flag = last;
            }
            __syncthreads();
            if (*flag) {
                const int wid = threadIdx.x >> 6, lane = threadIdx.x & 63;
                f32x4 g[4];
#pragma unroll
                for (int q = 0; q < 4; ++q) g[q] = *(const f32x4*)(gain + q * 256 + lane * 4);
                f32x4 v[4], vn[4];
                { const float* s = p.hmeta + (size_t)(wid * 16) * D;
#pragma unroll
                  for (int q = 0; q < 4; ++q) v[q] = *(const f32x4*)(s + q * 256 + lane * 4); }
                for (int rr = 0; rr < 16; ++rr) {
                    const int row = wid * 16 + rr;
                    { const float* s = p.hmeta + (size_t)(rr < 15 ? row + 1 : row) * D;
#pragma unroll
                      for (int q = 0; q < 4; ++q) vn[q] = *(const f32x4*)(s + q * 256 + lane * 4); }
                    float ss = 0.f;
#pragma unroll
                    for (int q = 0; q < 4; ++q) ss += v[q][0] * v[q][0] + v[q][1] * v[q][1] + v[q][2] * v[q][2] + v[q][3] * v[q][3];
#pragma unroll
                    for (int o = 32; o >= 1; o >>= 1) ss += __shfl_xor(ss, o);
                    const float rstd = rsqrtf(ss * (1.0f / D) + RMS_EPS);
                    bf16_t* dst = p.hn + (size_t)(MX + row) * D;
#pragma unroll
                    for (int q = 0; q < 4; ++q) { const f32x4 y = v[q] * rstd * g[q]; u32x2 w; w.x = cvt_pk_bf16(y[0], y[1]); w.y = cvt_pk_bf16(y[2], y[3]); *(u32x2*)(dst + q * 256 + lane * 4) = w; }
#pragma unroll
                    for (int q = 0; q < 4; ++q) v[q] = vn[q];
                }
            }
            __syncthreads();
        }
    }
    pg8::StaticOrder S; pg8::Gemm g{A, Bt, MX, D, K, lda}; S.init(g.M, g.N, gridDim.x, blockIdx.x);
    EpiResidNorm<HALFS, FINAL, BASEF32> E{base_x, p.out, p.hn, gain, p.xbuf + (size_t)inst * 64 * 256 * 4, p.xcnt + inst * 64 * 64};
    pg8::gemm_phase((LAS unsigned char*)shm, g, S, E);
}
__device__ __forceinline__ void ph_da_qk(const Params& p, unsigned char* shm) {
    const bf16_t* Bt = p.w_da_qk; const DstDaQK dst{p.qd, p.kh};
    SMALL_ITEMS(i, 2048 / 32) {
        auto fin = [=](int rb, const f32x4 (&s)[2], int fr, int fq) {
#pragma unroll
            for (int cb = 0; cb < 2; ++cb) { const int c = 32 * i + cb * 16 + fq * 4;
                bf16_t* d = c < 1024 ? dst.Qd + (size_t)(MX + rb * 16 + fr) * 1024 + c : dst.Kh + ((size_t)(rb * 8 + ((c - 1024) >> 7)) * NTOK + fr) * 128 + (c & 127);
                *(u32x2*)d = pack4(s[cb]); } };
        small_gemm_item<2, false>(shm, p.hn + (size_t)MX * D, D, Bt + (size_t)(32 * i) * D, Bt + (size_t)(32 * i + 16) * D, D, fin);
    }
    pg8::StaticOrder S; pg8::Gemm g{p.hn, Bt, MX, 2048, D, D}; S.init(g.M, g.N, gridDim.x, blockIdx.x);
    EpiBf16T<DstDaQK> E{dst}; pg8::gemm_phase((LAS unsigned char*)shm, g, S, E);
}
__device__ __forceinline__ void ph_gla_main(const Params& p, unsigned char* shm) {
    const bf16_t* Bt = p.w_gla_main; const DstGlaMain dst{p.qh, p.g2};
    SMALL_ITEMS(i, 2048 / 32) {
        auto fin = [=](int rb, const f32x4 (&s)[2], int fr, int fq) {
#pragma unroll
            for (int cb = 0; cb < 2; ++cb) { const int c = 32 * i + cb * 16 + fq * 4;
                bf16_t* d = c < 512 ? dst.qh + ((size_t)(rb * 4 + (c >> 7)) * NTOK + fr) * 128 + (c & 127) : dst.g2 + (size_t)(MX + rb * 16 + fr) * 1536 + (c - 512);
                *(u32x2*)d = pack4(s[cb]); } };
        small_gemm_item<2, false>(shm, p.hn + (size_t)MX * D, D, Bt + (size_t)(32 * i) * D, Bt + (size_t)(32 * i + 16) * D, D, fin);
    }
    pg8::StaticOrder S; pg8::Gemm g{p.hn, Bt, MX, 2048, D, D}; S.init(g.M, g.N, gridDim.x, blockIdx.x);
    EpiBf16T<DstGlaMain> E{dst}; pg8::gemm_phase((LAS unsigned char*)shm, g, S, E);
}
__device__ __forceinline__ void ph_vt(unsigned char* shm, const bf16_t* Wv, const bf16_t* hn, bf16_t* vtc) {
    SMALL_ITEMS(i, 1024 / 32) {
        auto fin = [=](int rb, const f32x4 (&s)[2], int fr, int fq) {
#pragma unroll
            for (int cb = 0; cb < 2; ++cb) *(u32x2*)(vtc + ((size_t)(rb * 33) * 1024 + 32 * i + cb * 16 + fr) * 64 + fq * 4) = pack4(s[cb]); };
        small_gemm_item<2, true>(shm, hn + (size_t)MX * D, D, Wv + (size_t)(32 * i) * D, Wv + (size_t)(32 * i + 16) * D, D, fin);
    }
    pg8::StaticOrder S; pg8::Gemm g{Wv, hn, 1024, MX, D, D}; S.init(g.M, g.N, gridDim.x, blockIdx.x);
    EpiBf16T<DstVTc> E{DstVTc{vtc}}; pg8::gemm_phase((LAS unsigned char*)shm, g, S, E);
}
__device__ __forceinline__ void ph_glr(const Params& p, unsigned char* shm) {
    SMALL_ITEMS(i, MTOT / 128) {
        float* G = p.glr;
        auto fin = [=](int rb, const f32x4 (&s)[1], int fr, int fq) { *(f32x4*)(G + (size_t)(128 * i + rb * 16 + fr) * 16 + fq * 4) = s[0]; };
        const bf16_t* Wg = p.w_gla_main + (size_t)2048 * D;
        small_gemm_item<1, false>(shm, p.hn + (size_t)(128 * i) * D, D, Wg, Wg, D, fin);
    }
}

constexpr int NPHASES = 24;
#define XB_TMO      128
#define XB_XCNT(j)  (256  + 64 * (j))
#define XB_XSUB(j)  (1280 + 64 * (j))
#define XB_XGEN(j)  (2304 + 64 * (j))
#define XB_TOP      3328
#define XB_TOPGEN   3392
#define XCD_BAR_WORDS 3456
#define XB_SPIN_CAP (1u << 18)
__device__ __forceinline__ unsigned xb_ld(unsigned* p)              { return __hip_atomic_load(p, __ATOMIC_RELAXED, __HIP_MEMORY_SCOPE_AGENT); }
__device__ __forceinline__ unsigned xb_add(unsigned* p, unsigned v) { return __hip_atomic_fetch_add(p, v, __ATOMIC_RELAXED, __HIP_MEMORY_SCOPE_AGENT); }
__device__ __forceinline__ unsigned xb_xcc_id() { return (unsigned)__builtin_amdgcn_s_getreg((3 << 11) | 20) & 0xFu; }
#define XB_SPIN(cond, bar) do { unsigned _sp = 0; while (cond) { __builtin_amdgcn_s_sleep(1); \
    if ((++_sp & 255u) == 0u) { if (xb_ld(&(bar)[XB_TMO])) break; if (_sp > XB_SPIN_CAP) { atomicAdd(&(bar)[XB_TMO], 1u); break; } } } } while (0)
struct XcdBarrier { unsigned* bar; unsigned x; volatile LAS unsigned* st; };
__device__ __forceinline__ XcdBarrier xcd_barrier_post(unsigned* bar, volatile LAS unsigned* st) {
    XcdBarrier b; b.bar = bar; b.x = xb_xcc_id(); b.st = st;
    if (threadIdx.x == 0) (void)xb_add(&bar[XB_XCNT(b.x)], 1u);
    return b;
}
__device__ __forceinline__ void xcd_barrier_complete(unsigned* bar, unsigned x, unsigned& nloc, unsigned& nx) {
    const unsigned G = gridDim.x * gridDim.y * gridDim.z;
    unsigned sum, cnt, mine, sp = 0u;
    for (;;) {
        sum = 0u; cnt = 0u; mine = 0u;
#pragma unroll
        for (unsigned j = 0; j < 16; ++j) { const unsigned c = xb_ld(&bar[XB_XCNT(j)]); sum += c; cnt += (c > 0u) ? 1u : 0u; mine = (j == x) ? c : mine; }
        if (sum == G) break;
        __builtin_amdgcn_s_sleep(1);
        if ((++sp & 255u) == 0u) { if (xb_ld(&bar[XB_TMO])) break; if (sp > XB_SPIN_CAP) { atomicAdd(&bar[XB_TMO], 1u); break; } }
    }
    nloc = mine > 0u ? mine : 1u; nx = cnt > 0u ? cnt : 1u;
}
__device__ __attribute__((noinline)) void xcd_barrier(unsigned* barp) {
    extern __shared__ __attribute__((aligned(16))) unsigned char shm_xb[];
    XcdBarrier b; b.bar = barp; b.x = xb_xcc_id(); b.st = (volatile LAS unsigned*)((LAS unsigned char*)shm_xb + LDS_BYTES);
    asm volatile("s_waitcnt vmcnt(0)" ::: "memory");
    __syncthreads();
    if (threadIdx.x == 0) {
        unsigned* bar = b.bar;
        __builtin_amdgcn_s_waitcnt(0);
        unsigned nloc = b.st[0], nx = b.st[1];
        if (nloc == 0u) { xcd_barrier_complete(bar, b.x, nloc, nx); b.st[0] = nloc; b.st[1] = nx; }
        const unsigned old = xb_add(&bar[XB_XSUB(b.x)], 1u);
        const unsigned gen = old / nloc;
        if (old + 1u == (gen + 1u) * nloc) {
            __builtin_amdgcn_fence(__ATOMIC_RELEASE, "agent");
            asm volatile("s_waitcnt vmcnt(0)" ::: "memory");
            const unsigned og = xb_add(&bar[XB_TOP], 1u);
            const unsigned tg = og / nx;
            if (og + 1u == (tg + 1u) * nx) xb_add(&bar[XB_TOPGEN], 1u);
            else XB_SPIN(xb_ld(&bar[XB_TOPGEN]) == tg, bar);
            __builtin_amdgcn_fence(__ATOMIC_ACQUIRE, "agent");
            xb_add(&bar[XB_XGEN(b.x)], 1u);
            asm volatile("s_waitcnt vmcnt(0)" ::: "memory");
        } else {
            XB_SPIN(xb_ld(&bar[XB_XGEN(b.x)]) == gen, bar);
            __builtin_amdgcn_fence(__ATOMIC_ACQUIRE, "agent");
            asm volatile("s_waitcnt vmcnt(0)" ::: "memory");
        }
    }
    __syncthreads();
}
#ifndef PROBE_MASK
#define PROBE_MASK 0u
#endif
#define RUN(idx, ...) if (p.ph_lo <= (idx) && (idx) < p.ph_hi) { if ((PROBE_MASK >> (idx)) & 1u) { __VA_ARGS__; xcd_barrier(p.bar); } __VA_ARGS__; if ((idx) < 22 && (idx) + 1 < p.ph_hi) xcd_barrier(p.bar); }

__global__ void __launch_bounds__(512, 2) fwd_megakernel(const Params p) {
    extern __shared__ __attribute__((aligned(16))) unsigned char shm[];
    cg::grid_group grid = cg::this_grid();
    if (p.ph_hi > 1000) grid.sync();
    volatile LAS unsigned* xst = (volatile LAS unsigned*)((LAS unsigned char*)shm + LDS_BYTES);
    if (threadIdx.x == 0) { xst[0] = 0u; xst[1] = 0u; }
    __syncthreads();
    (void)xcd_barrier_post(p.bar, xst);
    RUN(0, prep_phase(p, shm); norm_phase(p, p.x, p.ffn1_norm, false, true))
    RUN(2, ph_ffn_in(p, shm, 0))
    RUN(3, (ph_resid<true, false, true>(p, shm, p.big, DFF, p.w_ffn_out[0], DFF, p.x, p.mix_norm, 0)))
    RUN(5, ph_da_qk(p, shm); ph_vt(shm, p.w_da_v, p.hn, p.vtc_da))
    RUN(6, attn_phase(p, shm))
    RUN(7, (ph_resid<false, false, false>(p, shm, p.qd, D, p.w_da_out, D, p.out, p.ffn2_norm, 1)))
    RUN(9, ph_ffn_in(p, shm, 1))
    RUN(10, (ph_resid<true, false, false>(p, shm, p.big, DFF, p.w_ffn_out[1], DFF, p.out, p.ffn1_norm + D, 2)))
    RUN(12, ph_ffn_in(p, shm, 2))
    RUN(13, (ph_resid<true, false, false>(p, shm, p.big, DFF, p.w_ffn_out[2], DFF, p.out, p.mix_norm + D, 3)))
    RUN(15, ph_glr(p, shm); ph_gla_main(p, shm); ph_vt(shm, p.w_gla_v, p.hn, p.vtc_gla))
    RUN(16, gla_prep_phase(p, shm))
    RUN(17, gla_scan_phase(p, shm))
    RUN(18, gla_post_phase(p))
    RUN(19, (ph_resid<false, false, false>(p, shm, p.g2 + 512, 1536, p.w_gla_out, D, p.out, p.ffn2_norm + D, 4)))
    RUN(21, ph_ffn_in(p, shm, 3))
    RUN(22, (ph_resid<true, true, false>(p, shm, p.big, DFF, p.w_ffn_out[3], DFF, p.out, p.final_norm, 5)))
}

#ifndef N_LAUNCH_MODE
#define N_LAUNCH_MODE 0
#endif

extern "C" void kernel_launch(void* const* d_in, const int* in_sizes, int n_in, void* d_out, int out_size, void* d_ws, size_t ws_size, hipStream_t stream) {
    (void)in_sizes; (void)n_in; (void)out_size;
    Params p; memset(&p, 0, sizeof(p));
    const float* x = (const float*)d_in[0];
    p.x = x; p.meta = (const float*)d_in[1]; p.ffn1_norm = (const float*)d_in[2];
    const float* ffn1_w_in = (const float*)d_in[3]; const float* ffn1_w_out = (const float*)d_in[4];
    p.mix_norm = (const float*)d_in[5]; p.ffn2_norm = (const float*)d_in[6];
    const float* ffn2_w_in = (const float*)d_in[7]; const float* ffn2_w_out = (const float*)d_in[8];
    const float* da_w_in = (const float*)d_in[9]; p.da_lambda = (const float*)d_in[10]; p.da_subln = (const float*)d_in[11];
    const float* da_w_out = (const float*)d_in[12]; const float* gla_w_in = (const float*)d_in[13];
    p.gla_w_gate2 = (const float*)d_in[14]; p.gla_b_gate2 = (const float*)d_in[15]; p.gla_norm = (const float*)d_in[16];
    const float* gla_w_out = (const float*)d_in[17]; p.final_norm = (const float*)d_in[18];
    p.out = (float*)d_out;

    char* ws = (char*)d_ws; size_t off = 0;
    auto take = [&](size_t bytes) { char* r = ws + off; off += (bytes + 255) & ~(size_t)255; return r; };
    for (int i = 0; i < 4; ++i) p.w_ffn_in[i] = (bf16_t*)take((size_t)2 * DFF * D * 2);
    for (int i = 0; i < 4; ++i) p.w_ffn_out[i] = (bf16_t*)take((size_t)D * DFF * 2);
    p.w_da_qk = (bf16_t*)take((size_t)2048 * D * 2); p.w_da_v = (bf16_t*)take((size_t)1024 * D * 2); p.w_da_out = (bf16_t*)take((size_t)1024 * D * 2);
    p.w_gla_main = (bf16_t*)take((size_t)2304 * D * 2); p.w_gla_v = (bf16_t*)take((size_t)1024 * D * 2); p.w_gla_out = (bf16_t*)take((size_t)1024 * D * 2);
    p.big = (bf16_t*)take((size_t)51314688 * 2);
    p.qd = p.big; p.kh = p.big + (size_t)MP * 1024; p.vtc_da = p.kh + (size_t)64 * NTOK * 128;
    p.g2 = p.big; p.qh = p.big + (size_t)MP * 1536; p.vtc_gla = p.qh + (size_t)32 * NTOK * 128;
    p.hn = (bf16_t*)take((size_t)MP * D * 2);
    p.kdecT = (bf16_t*)take((size_t)NB * 33 * 512 * 64 * 2);
    p.hmeta = (float*)take((size_t)256 * D * 4);
    p.glr = (float*)take((size_t)MP * 16 * 4);
    p.decay = (float*)take((size_t)NB * 33 * 512 * 4);
    p.bar = (unsigned*)take((size_t)(XCD_BAR_WORDS + XCNT_WORDS) * 4); p.xcnt = p.bar + XCD_BAR_WORDS;
    p.xbuf = (float*)take((size_t)6 * 64 * 256 * 4 * 4);
    if (off > ws_size) { fprintf(stderr, "workspace too small: need %zu have %zu\n", off, ws_size); return; }

    int nj = 0, tiles = 0;
    auto add = [&](const float* src, bf16_t* dst, int ldw, int K, int ndst, int col0, int mode, int nvalid) {
        Job& j = p.jobs[nj++]; j.src = src; j.dst = dst; j.ldw = ldw; j.K = K; j.ndst = ndst; j.col0 = col0; j.mode = mode; j.nvalid = nvalid; j.tile0 = tiles; j.pad = 0;
        tiles += (K / 128) * (ndst / 128); };
    add(ffn1_w_in, p.w_ffn_in[0], 2 * DFF, D, 2 * DFF, 0, 1, 2 * DFF);
    add(ffn2_w_in, p.w_ffn_in[1], 2 * DFF, D, 2 * DFF, 0, 1, 2 * DFF);
    add(ffn1_w_in + (size_t)D * 2 * DFF, p.w_ffn_in[2], 2 * DFF, D, 2 * DFF, 0, 1, 2 * DFF);
    add(ffn2_w_in + (size_t)D * 2 * DFF, p.w_ffn_in[3], 2 * DFF, D, 2 * DFF, 0, 1, 2 * DFF);
    add(ffn1_w_out, p.w_ffn_out[0], D, DFF, D, 0, 0, D);
    add(ffn2_w_out, p.w_ffn_out[1], D, DFF, D, 0, 0, D);
    add(ffn1_w_out + (size_t)DFF * D, p.w_ffn_out[2], D, DFF, D, 0, 0, D);
    add(ffn2_w_out + (size_t)DFF * D, p.w_ffn_out[3], D, DFF, D, 0, 0, D);
    add(da_w_in, p.w_da_qk, 3072, D, 2048, 0, 0, 2048);
    add(da_w_in, p.w_da_v, 3072, D, 1024, 2048, 0, 1024);
    add(da_w_out, p.w_da_out, D, D, D, 0, 0, D);
    add(gla_w_in, p.w_gla_main, 3088, D, 1024, 0, 0, 1024);
    add(gla_w_in, p.w_gla_main + (size_t)1024 * D, 3088, D, 1024, 2048, 0, 1024);
    add(gla_w_in, p.w_gla_main + (size_t)2048 * D, 3088, D, 256, 3072, 0, 16);
    add(gla_w_in, p.w_gla_v, 3088, D, 1024, 1024, 0, 1024);
    add(gla_w_out, p.w_gla_out, D, D, D, 0, 0, D);
    p.njobs = nj; p.ntiles_prep = tiles;

    static int grid_blocks = 0;
    if (!grid_blocks) {
        (void)hipFuncSetAttribute((const void*)fwd_megakernel, hipFuncAttributeMaxDynamicSharedMemorySize, LDS_TOTAL);
        int dev = 0, cus = 0, per_cu = 0;
        (void)hipGetDevice(&dev);
        (void)hipDeviceGetAttribute(&cus, hipDeviceAttributeMultiprocessorCount, dev);
        (void)hipOccupancyMaxActiveBlocksPerMultiprocessor(&per_cu, fwd_megakernel, 512, LDS_TOTAL);
        if (per_cu > 1) per_cu = 1;
        grid_blocks = cus * per_cu;
        if (grid_blocks <= 0) grid_blocks = 256;
    }
#if N_LAUNCH_MODE == 1
    for (int ph = 0; ph < NPHASES; ++ph) {
        p.ph_lo = ph; p.ph_hi = ph + 1;
        hipLaunchKernelGGL(fwd_megakernel, dim3(grid_blocks), dim3(512), LDS_TOTAL, stream, p);
    }
#else
    p.ph_lo = 0; p.ph_hi = NPHASES;
    (void)hipMemsetAsync(p.bar, 0, (size_t)XCD_BAR_WORDS * 4, stream);
    void* args[] = {(void*)&p};
    hipError_t e = hipLaunchCooperativeKernel((const void*)fwd_megakernel, dim3(grid_blocks), dim3(512), args, LDS_TOTAL, stream);
    if (e != hipSuccess) fprintf(stderr, "cooperative launch failed: %s (grid %d)\n", hipGetErrorString(e), grid_blocks);
#endif
}
```

```cpp
#include <hip/hip_runtime.h>
#include <hip/hip_cooperative_groups.h>
#include <cstdio>
#include <cstring>
namespace cg = cooperative_groups;

#define LAS __attribute__((address_space(3)))
typedef unsigned short bf16_t;
typedef short bf16x8 __attribute__((ext_vector_type(8)));
typedef float f32x4 __attribute__((ext_vector_type(4)));
typedef float f32x2 __attribute__((ext_vector_type(2)));
typedef unsigned u32x4 __attribute__((ext_vector_type(4)));
typedef unsigned u32x2 __attribute__((ext_vector_type(2)));

constexpr int D = 1024, NB = 8, SEQ = 2048, DFF = 2816;
constexpr int MX = NB * SEQ;
constexpr int MMETA = NB * 16;
constexpr int MTOT = MX + MMETA;
constexpr int MP = 16640;
constexpr int LDS_BYTES = 131072;
constexpr int LDS_TOTAL = LDS_BYTES + 16;
constexpr float RMS_EPS = 1e-6f;
#define XCNT_WORDS (6 * 64 * 64 + 6 * 64)

typedef __bf16 bf16x2_t __attribute__((ext_vector_type(2)));
__device__ __forceinline__ unsigned cvt_pk_bf16(float lo, float hi) { const f32x2 v = {lo, hi}; const bf16x2_t b = __builtin_convertvector(v, bf16x2_t); return __builtin_bit_cast(unsigned, b); }
__device__ __forceinline__ void store_wt16(void* p, u32x4 v) { asm volatile("global_store_dwordx4 %0, %1, off sc1\n\ts_nop 1" :: "v"(p), "v"(v) : "memory"); }
__device__ __forceinline__ float bf2f(unsigned short b) { return __uint_as_float(((unsigned)b) << 16); }
__device__ __forceinline__ float bflo(unsigned w) { return __uint_as_float(w << 16); }
__device__ __forceinline__ float bfhi(unsigned w) { return __uint_as_float(w & 0xffff0000u); }

namespace pg8 {
constexpr int BM = 256, BK = 64, HALF = 128, HTB = HALF * BK * 2, STAGE_BYTES = 8 * HTB, NXCD = 8, WGM = 8;
__host__ __device__ __forceinline__ int lds_byte(int r, int c) { const int st = (r >> 4) * 2 + (c >> 5), rr = r & 15, cc = c & 31, ob = rr * 64 + cc * 2; return st * 1024 + (ob ^ (((ob >> 9) & 1) << 5)); }
__host__ __device__ __forceinline__ void stage_rc(int b, int& R, int& C) { const int st = b / 1024, sb = b % 1024, swz = sb ^ (((sb >> 9) & 1) << 5); R = (st >> 1) * 16 + swz / 64; C = (st & 1) * 32 + (swz % 64) / 2; }
__host__ __device__ __forceinline__ int perm32(int rho) { const int n = rho >> 4, i = rho & 15; return 8 * (i >> 2) + 4 * n + (i & 3); }

struct Unit { int pm, pn; };
struct Gemm { const bf16_t* A; const bf16_t* Bt; int M, N, K, lda; };
struct StaticOrder {
    int nM, nN, nwg, G, c, mode;
    __device__ void init(int M, int N, int G_, int c_, int mode_ = 0) { nM = M / BM; nN = N / BM; nwg = nM * nN; G = G_; c = c_; mode = mode_; }
    __device__ bool split_tail() const { const int rem = nwg % G; return rem > 0 && 2 * rem <= G; }
    __device__ bool next(int i, Unit& u) const {
        long L;
        if (mode == 2) { const int full = nwg / G, rem = nwg - full * G; if (i != 0 || c >= 2 * rem) return false; L = (long)full * G + (c >> 1); }
        else { L = (long)i * G + c; if (L >= nwg) return false; if (mode == 1 && i >= nwg / G) return false; }
        int wgid = (int)L; { const int q = nwg / NXCD, r = nwg % NXCD, xcd = wgid % NXCD, off = wgid / NXCD; wgid = (xcd < r ? xcd * (q + 1) : r * (q + 1) + (xcd - r) * q) + off; }
        const int nig = WGM * nN, gid = wgid / nig, fm = gid * WGM, gsz = (nM - fm) < WGM ? (nM - fm) : WGM;
        u.pm = fm + ((wgid % nig) % gsz); u.pn = (wgid % nig) / gsz; return true;
    }
};

template <class Epi, int HSEL = 0>
__device__ __forceinline__ void gemm_phase(LAS unsigned char* lds, const Gemm g, const StaticOrder& S, const Epi& E) {
    const int tid = threadIdx.x, wid = __builtin_amdgcn_readfirstlane(tid >> 6), lane = tid & 63, wr = wid >> 2, wc = wid & 3, fr = lane & 15, fq = lane >> 4;
    const int K = g.K, nt = K / BK;
    unsigned voffA[2], voffB[2];
#pragma unroll
    for (int i = 0; i < 2; ++i) { int R, C; stage_rc(tid * 16 + i * 8192, R, C); const int Rb = Epi::PERM ? ((R & ~31) + perm32(R & 31)) : R;
        voffA[i] = (unsigned)(R * g.lda + C) * 2u; voffB[i] = (unsigned)(Rb * K + C) * 2u; }
    const size_t kstep = (size_t)(BK * 2);
    const size_t hstep = (size_t)HALF * K * 2, hstepA = (size_t)HALF * g.lda * 2;
    const size_t tstep = 2 * hstep, tstepA = 2 * hstepA;
    const unsigned ldsw = (unsigned)wid * 1024u;
    const int aoff = lds_byte(wr * 64 + fr, fq * 8), boff = lds_byte(wc * 32 + fr, fq * 8);
#define PG8_SA(b, h) (((b) * 2 + (h)) * HTB)
#define PG8_SB(b, h) ((4 + (b) * 2 + (h)) * HTB)
#define PG8_STAGE(bufoff, gbase, voff) do { _Pragma("unroll") for (int _i = 0; _i < 2; ++_i) \
        __builtin_amdgcn_global_load_lds((const unsigned*)((const char*)(gbase) + (voff)[_i]), (LAS unsigned*)(lds + (bufoff) + ldsw + _i * 8192), 16, 0, 0); } while (0)
#define PG8_LDA(dst, b, h) do { _Pragma("unroll") for (int m = 0; m < 4; ++m) _Pragma("unroll") for (int k = 0; k < 2; ++k) dst[m][k] = *(const LAS bf16x8*)(lds + PG8_SA(b, h) + aoff + m * 2048 + k * 1024); } while (0)
#define PG8_LDB(dst, b, h) do { _Pragma("unroll") for (int n = 0; n < 2; ++n) _Pragma("unroll") for (int k = 0; k < 2; ++k) dst[n][k] = *(const LAS bf16x8*)(lds + PG8_SB(b, h) + boff + n * 2048 + k * 1024); } while (0)
#define PG8_MMA(ai, bj, At, Bt) do { __builtin_amdgcn_s_setprio(1); _Pragma("unroll") for (int m = 0; m < 4; ++m) _Pragma("unroll") for (int n = 0; n < 2; ++n) _Pragma("unroll") for (int k = 0; k < 2; ++k) \
        acc[ai][bj][m][n] = __builtin_amdgcn_mfma_f32_16x16x32_bf16(Bt[n][k], At[m][k], acc[ai][bj][m][n], 0, 0, 0); __builtin_amdgcn_s_setprio(0); } while (0)
#define PG8_KEEPA(X) do { _Pragma("unroll") for (int m = 0; m < 4; ++m) _Pragma("unroll") for (int k = 0; k < 2; ++k) asm volatile("" :: "v"(X[m][k])); } while (0)
#define PG8_WAIT_V(n) asm volatile("s_waitcnt vmcnt(" #n ")" ::: "memory")
#define PG8_WAIT_L(n) asm volatile("s_waitcnt lgkmcnt(" #n ")" ::: "memory")
#define PG8_BAR __builtin_amdgcn_s_barrier()
#define PG8_SCHED __builtin_amdgcn_sched_barrier(0)
    Unit cur, nxt; int ui = 0;
    if (!S.next(0, cur)) return;
    f32x4 acc[2][2][4][2];
#pragma unroll
    for (int a = 0; a < 2; ++a)
#pragma unroll
        for (int b = 0; b < 2; ++b)
#pragma unroll
            for (int m = 0; m < 4; ++m)
#pragma unroll
                for (int n = 0; n < 2; ++n) acc[a][b][m][n] = (f32x4){0.f, 0.f, 0.f, 0.f};
    bf16x8 At[4][2], B0[2][2], B1[2][2];
    const char* cA = (const char*)g.A + (size_t)cur.pm * tstepA; const char* cB = (const char*)g.Bt + (size_t)cur.pn * tstep;
    PG8_STAGE(PG8_SB(0, 0), cB, voffB); PG8_STAGE(PG8_SA(0, 0), cA, voffA); PG8_STAGE(PG8_SB(0, 1), cB + hstep, voffB); PG8_STAGE(PG8_SA(0, 1), cA + hstepA, voffA);
    if (wr == 1) PG8_BAR;
    PG8_WAIT_V(4); PG8_BAR;
    PG8_STAGE(PG8_SB(1, 0), cB + kstep, voffB); PG8_STAGE(PG8_SA(1, 0), cA + kstep, voffA); PG8_STAGE(PG8_SB(1, 1), cB + hstep + kstep, voffB);
    PG8_WAIT_V(6); PG8_BAR;
    for (;;) {
        const bool has_next = S.next(ui + 1, nxt);
        const char* nA = has_next ? (const char*)g.A + (size_t)nxt.pm * tstepA : cA; const char* nB = has_next ? (const char*)g.Bt + (size_t)nxt.pn * tstep : cB;
        for (int t = 0; t < nt; t += 2) {
            const bool last = (t == nt - 2);
            const char* a1 = cA + (size_t)(t + 1) * kstep;
            const char* a2 = last ? nA : cA + (size_t)(t + 2) * kstep; const char* b2 = last ? nB : cB + (size_t)(t + 2) * kstep;
            const char* a3 = a2 + kstep; const char* b3 = b2 + kstep;
            PG8_LDB(B0, 0, 0); PG8_SCHED; PG8_LDA(At, 0, 0); PG8_STAGE(PG8_SA(1, 1), a1 + hstepA, voffA);
            PG8_WAIT_L(8); PG8_BAR; PG8_WAIT_L(0); if (HSEL != 2) PG8_MMA(0, 0, At, B0); else PG8_KEEPA(At); PG8_BAR; PG8_SCHED;
            PG8_LDB(B1, 0, 1); PG8_STAGE(PG8_SB(0, 0), b2, voffB);
            PG8_BAR; PG8_WAIT_L(0); if (HSEL != 2) PG8_MMA(0, 1, At, B1); else PG8_KEEPA(At); PG8_BAR;
            PG8_LDA(At, 0, 1); PG8_STAGE(PG8_SA(0, 0), a2, voffA);
            PG8_BAR; PG8_WAIT_L(0); if (HSEL != 1) PG8_MMA(1, 0, At, B0); else PG8_KEEPA(At); PG8_BAR; PG8_SCHED;
            PG8_STAGE(PG8_SB(0, 1), b2 + hstep, voffB);
            PG8_WAIT_V(6); PG8_BAR; if (HSEL != 1) PG8_MMA(1, 1, At, B1); else PG8_KEEPA(At); PG8_BAR;
            PG8_LDB(B0, 1, 0); PG8_SCHED; PG8_LDA(At, 1, 0); PG8_STAGE(PG8_SA(0, 1), a2 + hstepA, voffA);
            PG8_WAIT_L(8); PG8_BAR; PG8_WAIT_L(0); if (HSEL != 2) PG8_MMA(0, 0, At, B0); else PG8_KEEPA(At); PG8_BAR; PG8_SCHED;
            PG8_LDB(B1, 1, 1); PG8_STAGE(PG8_SB(1, 0), b3, voffB);
            PG8_BAR; PG8_WAIT_L(0); if (HSEL != 2) PG8_MMA(0, 1, At, B1); else PG8_KEEPA(At); PG8_BAR;
            PG8_LDA(At, 1, 1); PG8_STAGE(PG8_SA(1, 0), a3, voffA);
            PG8_BAR; PG8_WAIT_L(0); if (HSEL != 1) PG8_MMA(1, 0, At, B0); else PG8_KEEPA(At); PG8_BAR; PG8_SCHED;
            PG8_STAGE(PG8_SB(1, 1), b3 + hstep, voffB);
            PG8_WAIT_V(6); PG8_BAR; if (HSEL != 1) PG8_MMA(1, 1, At, B1); else PG8_KEEPA(At); PG8_BAR;
        }
        if constexpr (!Epi::AFTER_DRAIN) E(acc, cur, wr, wc, fr, fq, HSEL);
        if (!has_next) break;
#pragma unroll
        for (int a = 0; a < 2; ++a)
#pragma unroll
            for (int b = 0; b < 2; ++b)
#pragma unroll
                for (int m = 0; m < 4; ++m)
#pragma unroll
                    for (int n = 0; n < 2; ++n) acc[a][b][m][n] = (f32x4){0.f, 0.f, 0.f, 0.f};
        cur = nxt; cA = nA; cB = nB; ++ui;
    }
    PG8_WAIT_V(0);
    if (wr == 0) PG8_BAR;
    PG8_BAR;
    if constexpr (Epi::AFTER_DRAIN) E.fused(acc, cur, wr, wc, fr, fq, lds, wid, lane);
#undef PG8_SA
#undef PG8_SB
#undef PG8_STAGE
#undef PG8_LDA
#undef PG8_LDB
#undef PG8_MMA
#undef PG8_KEEPA
#undef PG8_WAIT_V
#undef PG8_WAIT_L
#undef PG8_BAR
#undef PG8_SCHED
}
}
using pg8::Unit;

__device__ __forceinline__ float silu_f(float g) { return g * __builtin_amdgcn_rcpf(1.0f + __expf(-g)); }

struct EpiSwiGLU {
    static constexpr bool PERM = true, AFTER_DRAIN = false;
    bf16_t* O;
    __device__ __forceinline__ void operator()(const f32x4 (&acc)[2][2][4][2], const Unit& u, int wr, int wc, int fr, int fq, int half) const {
        const int row0 = u.pm * 256 + wr * 64 + fr, col0 = u.pn * 128 + wc * 32 + 8 * fq;
#pragma unroll
        for (int ai = 0; ai < 2; ++ai) {
            if (half == 2 - ai) continue;
#pragma unroll
            for (int m = 0; m < 4; ++m) {
                bf16_t* rowp = O + (size_t)(row0 + ai * 128 + m * 16) * DFF + col0;
                const f32x4 g0 = acc[ai][0][m][0], g1 = acc[ai][0][m][1], u0 = acc[ai][1][m][0], u1 = acc[ai][1][m][1];
                u32x4 w;
                w.x = cvt_pk_bf16(silu_f(g0[0]) * u0[0], silu_f(g0[1]) * u0[1]); w.y = cvt_pk_bf16(silu_f(g0[2]) * u0[2], silu_f(g0[3]) * u0[3]);
                w.z = cvt_pk_bf16(silu_f(g1[0]) * u1[0], silu_f(g1[1]) * u1[1]); w.w = cvt_pk_bf16(silu_f(g1[2]) * u1[2], silu_f(g1[3]) * u1[3]);
                store_wt16(rowp, w);
            }
        }
    }
};
struct EpiResid {
    static constexpr bool PERM = false, AFTER_DRAIN = false;
    const float* base_x; float* out_x; float scale;
    __device__ __forceinline__ void operator()(const f32x4 (&acc)[2][2][4][2], const Unit& u, int wr, int wc, int fr, int fq, int half) const {
        const int col0 = u.pn * 256 + wc * 32 + 4 * fq;
        const int row0 = u.pm * 256 + wr * 64 + fr;
#pragma unroll
        for (int ai = 0; ai < 2; ++ai) {
            if (half == 2 - ai) continue;
#pragma unroll
            for (int m = 0; m < 4; ++m) {
                const size_t off = (size_t)(row0 + ai * 128 + m * 16) * D + col0;
#pragma unroll
                for (int bj = 0; bj < 2; ++bj)
#pragma unroll
                    for (int n = 0; n < 2; ++n) {
                        const f32x4 b = *(const f32x4*)(base_x + off + bj * 128 + n * 16);
                        *(f32x4*)(out_x + off + bj * 128 + n * 16) = b + scale * acc[ai][bj][m][n];
                    }
            }
        }
    }
};
__device__ __forceinline__ bf16_t* hb_ptr(float* out, int r, int c) { return (bf16_t*)out + ((size_t)(r >> 8) * (256 * 1024 * 2) + (size_t)(r & 255) * 1024 + c); }
template <bool HALFS, bool FINAL, bool BASEF32> struct EpiResidNorm {
    static constexpr bool PERM = true, AFTER_DRAIN = true;
    const float* base_x; float* out_x; bf16_t* hn; const float* gain; float* xbuf; unsigned* cnt;
    __device__ __forceinline__ void fused(f32x4 (&acc)[2][2][4][2], const Unit& u, int wr, int wc, int fr, int fq, LAS unsigned char* lds, int wid, int lane) const {
        constexpr float scale = HALFS ? 0.5f : 1.0f;
        LAS float* P = (LAS float*)lds;
        LAS float* S = (LAS float*)(lds + 4096);
        const int col0 = u.pn * 256 + wc * 32 + 8 * fq, rt0 = wr * 64 + fr, tid = wid * 64 + lane;
#pragma unroll
        for (int ai = 0; ai < 2; ++ai)
#pragma unroll
            for (int m = 0; m < 4; ++m) {
                const int rt = rt0 + ai * 128 + m * 16, r = u.pm * 256 + rt;
                float ss = 0.f;
#pragma unroll
                for (int bj = 0; bj < 2; ++bj) {
                    f32x4 b0, b1;
                    if (BASEF32) { const float* bp = base_x + (size_t)r * D + col0 + bj * 128; b0 = __builtin_nontemporal_load((const f32x4*)bp); b1 = __builtin_nontemporal_load((const f32x4*)(bp + 4)); }
                    else { const u32x4 w = *(const u32x4*)hb_ptr(out_x, r, col0 + bj * 128); b0 = (f32x4){bflo(w.x), bfhi(w.x), bflo(w.y), bfhi(w.y)}; b1 = (f32x4){bflo(w.z), bfhi(w.z), bflo(w.w), bfhi(w.w)}; }
                    const f32x4 v0 = b0 + scale * acc[ai][bj][m][0], v1 = b1 + scale * acc[ai][bj][m][1];
                    acc[ai][bj][m][0] = v0; acc[ai][bj][m][1] = v1;
                    ss += (v0[0] * v0[0] + v0[1] * v0[1] + v0[2] * v0[2] + v0[3] * v0[3]) + (v1[0] * v1[0] + v1[1] * v1[1] + v1[2] * v1[2] + v1[3] * v1[3]);
                }
                ss += __shfl_xor(ss, 16); ss += __shfl_xor(ss, 32);
                if (fq == 0) P[rt * 4 + wc] = ss;
                if (BASEF32 || m == 3) asm volatile("" ::: "memory");
            }
        asm volatile("s_waitcnt lgkmcnt(0)" ::: "memory"); __builtin_amdgcn_s_barrier(); asm volatile("" ::: "memory");
        if (tid < 256) {
            const f32x4 q = *(const LAS f32x4*)(P + tid * 4);
            __hip_atomic_store(xbuf + ((size_t)u.pm * 256 + tid) * 4 + u.pn, (q[0] + q[1]) + (q[2] + q[3]), __ATOMIC_RELAXED, __HIP_MEMORY_SCOPE_AGENT);
        }
        asm volatile("s_waitcnt vmcnt(0)" ::: "memory");
        if (tid < 256 && lane == 0) __hip_atomic_fetch_add(cnt + 64 * u.pm, 1u, __ATOMIC_RELAXED, __HIP_MEMORY_SCOPE_AGENT);
        if (wid == 0) {
            unsigned sp = 0;
            while ((unsigned)__builtin_amdgcn_readfirstlane(__hip_atomic_load(cnt + 64 * u.pm, __ATOMIC_RELAXED, __HIP_MEMORY_SCOPE_AGENT)) < 16u) { __builtin_amdgcn_s_sleep(2); if (++sp > (1u << 20)) break; }
            __builtin_amdgcn_fence(__ATOMIC_ACQUIRE, "agent");
            asm volatile("s_waitcnt vmcnt(0)" ::: "memory");
        }
        asm volatile("s_waitcnt vmcnt(0) lgkmcnt(0)" ::: "memory"); __builtin_amdgcn_s_barrier(); asm volatile("" ::: "memory");
        if (tid < 256) {
            const float* slot = xbuf + ((size_t)u.pm * 256 + tid) * 4;
            const float a = __hip_atomic_load(slot + 0, __ATOMIC_RELAXED, __HIP_MEMORY_SCOPE_AGENT), b = __hip_atomic_load(slot + 1, __ATOMIC_RELAXED, __HIP_MEMORY_SCOPE_AGENT);
            const float c = __hip_atomic_load(slot + 2, __ATOMIC_RELAXED, __HIP_MEMORY_SCOPE_AGENT), d = __hip_atomic_load(slot + 3, __ATOMIC_RELAXED, __HIP_MEMORY_SCOPE_AGENT);
            S[tid] = rsqrtf(((a + b) + (c + d)) * (1.0f / D) + RMS_EPS);
        }
        asm volatile("s_waitcnt lgkmcnt(0)" ::: "memory"); __builtin_amdgcn_s_barrier(); asm volatile("" ::: "memory");
        f32x4 g[2][2];
#pragma unroll
        for (int bj = 0; bj < 2; ++bj)
#pragma unroll
            for (int n = 0; n < 2; ++n) g[bj][n] = *(const f32x4*)(gain + col0 + bj * 128 + n * 4);
#pragma unroll
        for (int ai = 0; ai < 2; ++ai)
#pragma unroll
            for (int m = 0; m < 4; ++m) {
                const int rt = rt0 + ai * 128 + m * 16;
                const size_t off = (size_t)(u.pm * 256 + rt) * D + col0;
                const float rs = S[rt];
#pragma unroll
                for (int bj = 0; bj < 2; ++bj) {
                    const f32x4 y0 = acc[ai][bj][m][0] * rs * g[bj][0], y1 = acc[ai][bj][m][1] * rs * g[bj][1];
                    if (FINAL) { __builtin_nontemporal_store(y0, (f32x4*)(out_x + off + bj * 128)); __builtin_nontemporal_store(y1, (f32x4*)(out_x + off + bj * 128 + 4)); }
                    else { u32x4 w; w.x = cvt_pk_bf16(y0[0], y0[1]); w.y = cvt_pk_bf16(y0[2], y0[3]); w.z = cvt_pk_bf16(y1[0], y1[1]); w.w = cvt_pk_bf16(y1[2], y1[3]); store_wt16(hn + off + bj * 128, w);
                           const f32x4 v0 = acc[ai][bj][m][0], v1 = acc[ai][bj][m][1];
                           u32x4 hw; hw.x = cvt_pk_bf16(v0[0], v0[1]); hw.y = cvt_pk_bf16(v0[2], v0[3]); hw.z = cvt_pk_bf16(v1[0], v1[1]); hw.w = cvt_pk_bf16(v1[2], v1[3]); store_wt16(hb_ptr(out_x, u.pm * 256 + rt, col0 + bj * 128), hw); }
                }
                asm volatile("" ::: "memory");
            }
    }
};
template <class Dst> struct EpiBf16T {
    static constexpr bool PERM = true, AFTER_DRAIN = false;
    Dst dst;
    __device__ __forceinline__ void operator()(const f32x4 (&acc)[2][2][4][2], const Unit& u, int wr, int wc, int fr, int fq, int half) const {
        const int row0 = u.pm * 256 + wr * 64 + fr, cw = wc * 32 + 8 * fq;
#pragma unroll
        for (int ai = 0; ai < 2; ++ai) {
            if (half == 2 - ai) continue;
#pragma unroll
            for (int m = 0; m < 4; ++m) {
                const int r = row0 + ai * 128 + m * 16;
#pragma unroll
                for (int bj = 0; bj < 2; ++bj) {
                    const f32x4 v0 = acc[ai][bj][m][0], v1 = acc[ai][bj][m][1];
                    u32x4 w; w.x = cvt_pk_bf16(v0[0], v0[1]); w.y = cvt_pk_bf16(v0[2], v0[3]); w.z = cvt_pk_bf16(v1[0], v1[1]); w.w = cvt_pk_bf16(v1[2], v1[3]);
                    store_wt16(dst(r, u.pn, bj, cw), w);
                }
            }
        }
    }
};
constexpr int NTOK = 16 + SEQ;
struct DstDaQK { bf16_t* Qd; bf16_t* Kh;
    __device__ __forceinline__ bf16_t* operator()(int r, int pn, int bj, int cw) const {
        if (pn < 4) return Qd + (size_t)r * 1024 + pn * 256 + bj * 128 + cw;
        const int b = r >> 11, s = r & 2047, h = 2 * (pn - 4) + bj;
        return Kh + ((size_t)(b * 8 + h) * NTOK + 16 + s) * 128 + cw; } };
struct DstGlaMain { bf16_t* qh; bf16_t* g2;
    __device__ __forceinline__ bf16_t* operator()(int r, int pn, int bj, int cw) const {
        if (pn >= 2) return g2 + (size_t)r * 1536 + (pn - 2) * 256 + bj * 128 + cw;
        const int b = r >> 11, s = r & 2047, h = 2 * pn + bj;
        return qh + ((size_t)(b * 4 + h) * NTOK + 16 + s) * 128 + cw; } };
struct DstVTc { bf16_t* vtc;
    __device__ __forceinline__ bf16_t* operator()(int f, int pn, int bj, int cw) const {
        const int tok = pn * 256 + bj * 128 + cw, b = tok >> 11, s = tok & 2047;
        return vtc + ((size_t)(b * 33 + 1 + (s >> 6)) * 1024 + f) * 64 + (s & 63); } };
struct Job { const float* src; bf16_t* dst; int ldw, K, ndst, col0, mode, nvalid, tile0, pad; };
struct Params {
    const float *x, *meta, *ffn1_norm, *mix_norm, *ffn2_norm, *da_lambda, *da_subln, *gla_w_gate2, *gla_b_gate2, *gla_norm, *final_norm;
    float* out;
    bf16_t* w_ffn_in[4]; bf16_t* w_ffn_out[4];
    bf16_t *w_da_qk, *w_da_v, *w_da_out, *w_gla_main, *w_gla_v, *w_gla_out;
    bf16_t *big, *hn, *kdecT;
    bf16_t *qd, *kh, *vtc_da, *g2, *qh, *vtc_gla;
    float *hmeta, *glr, *decay;
    unsigned* bar; unsigned* xcnt; float* xbuf;
    Job jobs[16];
    int njobs, ntiles_prep, ph_lo, ph_hi;
};

__device__ __forceinline__ void prep_phase(const Params& p, unsigned char* shm) {
    float* tile = (float*)shm;
    const int tid = threadIdx.x;
    const int n4 = (tid & 31) * 4, kk0 = tid >> 5;
#define PREP_FETCH(T, V, DST, KK, K0, N0, VALID) do { \
        int j_ = 0; for (int q = 1; q < p.njobs; ++q) if ((T) >= p.jobs[q].tile0) j_ = q; \
        const Job jb = p.jobs[j_]; \
        const int lt = (T) - jb.tile0, nkt = jb.K / 128, kt = lt % nkt, ntile = lt / nkt; \
        K0 = kt * 128; N0 = ntile * 128; KK = jb.K; DST = jb.dst; \
        int scol; if (jb.mode == 1) { const int pn = N0 >> 8, bj = (N0 >> 7) & 1; scol = bj * DFF + 128 * pn; } else scol = jb.col0 + N0; \
        VALID = N0 < jb.nvalid; \
        if (VALID) { \
            _Pragma("unroll") for (int i = 0; i < 8; ++i) { \
                const float* s = jb.src + (size_t)(K0 + kk0 + 16 * i) * jb.ldw + scol + n4; \
                if (N0 + n4 + 3 < jb.nvalid) V[i] = __builtin_nontemporal_load((const f32x4*)s);     \
                else { for (int q = 0; q < 4; ++q) V[i][q] = (N0 + n4 + q < jb.nvalid) ? s[q] : 0.f; } } } } while (0)
    f32x4 v[8], vn[8];
    bf16_t* dstc = nullptr; bf16_t* dstn = nullptr; int Kc = 0, k0c = 0, n0c = 0, Kn = 0, k0n = 0, n0n = 0; bool validc = false, validn = false;
    int t = blockIdx.x;
    if (t < p.ntiles_prep) PREP_FETCH(t, v, dstc, Kc, k0c, n0c, validc);
    for (; t < p.ntiles_prep; t += gridDim.x) {
        const int tn = t + gridDim.x;
        if (tn < p.ntiles_prep) PREP_FETCH(tn, vn, dstn, Kn, k0n, n0n, validn);
        __syncthreads();
        if (validc) {
#pragma unroll
            for (int i = 0; i < 8; ++i) { float* tp = tile + (kk0 + 16 * i) * 129 + n4; tp[0] = v[i][0]; tp[1] = v[i][1]; tp[2] = v[i][2]; tp[3] = v[i][3]; }
        }
        __syncthreads();
        const int nn = (tid & 31) + 32 * ((tid >> 6) & 3), ks = ((tid >> 5) & 1) + 2 * (tid >> 8);
        bf16_t* dp = dstc + (size_t)(n0c + nn) * Kc + k0c + ks * 32;
#pragma unroll
        for (int q4 = 0; q4 < 4; ++q4) {
            u32x4 w = (u32x4){0u, 0u, 0u, 0u};
            if (validc) {
                float x[8];
#pragma unroll
                for (int q = 0; q < 8; ++q) x[q] = tile[(ks * 32 + q4 * 8 + q) * 129 + nn];
                w.x = cvt_pk_bf16(x[0], x[1]); w.y = cvt_pk_bf16(x[2], x[3]); w.z = cvt_pk_bf16(x[4], x[5]); w.w = cvt_pk_bf16(x[6], x[7]);
            }
            *(u32x4*)(dp + q4 * 8) = w;
        }
#pragma unroll
        for (int i = 0; i < 8; ++i) v[i] = vn[i];
        dstc = dstn; Kc = Kn; k0c = k0n; n0c = n0n; validc = validn;
    }
#undef PREP_FETCH
    for (int i = blockIdx.x * 512 + tid; i < XCNT_WORDS; i += gridDim.x * 512) p.xcnt[i] = 0u;
    for (int i = blockIdx.x * 512 + tid; i < MMETA * D / 4; i += gridDim.x * 512) {
        const int row = i / (D / 4), c4 = i % (D / 4);
        ((f32x4*)p.hmeta)[i] = ((const f32x4*)p.meta)[(row & 15) * (D / 4) + c4];
    }
}

__device__ __forceinline__ void norm_phase(const Params& p, const float* srcx, const float* gain, bool final_out, bool first = false) {
    const int wid = threadIdx.x >> 6, lane = threadIdx.x & 63;
    const int nrows = final_out ? MX : MTOT, stride = gridDim.x * 8;
    f32x4 g[4];
#pragma unroll
    for (int i = 0; i < 4; ++i) g[i] = *(const f32x4*)(gain + i * 256 + lane * 4);
    auto rowsrc = [&](int row) { return row < MX ? srcx + (size_t)row * D : (first ? p.meta + (size_t)((row - MX) & 15) * D : p.hmeta + (size_t)(row - MX) * D); };
    int row = (first ? (int)(gridDim.x - 1 - blockIdx.x) : (int)blockIdx.x) * 8 + wid;
    f32x4 v[4], vn[4];
    if (row < nrows) { const float* src = rowsrc(row);
#pragma unroll
        for (int i = 0; i < 4; ++i) v[i] = first ? __builtin_nontemporal_load((const f32x4*)(src + i * 256 + lane * 4)) : *(const f32x4*)(src + i * 256 + lane * 4); }
    for (; row < nrows; row += stride) {
        const int nrow = row + stride;
        if (nrow < nrows) { const float* src = rowsrc(nrow);
#pragma unroll
            for (int i = 0; i < 4; ++i) vn[i] = first ? __builtin_nontemporal_load((const f32x4*)(src + i * 256 + lane * 4)) : *(const f32x4*)(src + i * 256 + lane * 4); }
        float ss = 0.f;
#pragma unroll
        for (int i = 0; i < 4; ++i) ss += v[i][0] * v[i][0] + v[i][1] * v[i][1] + v[i][2] * v[i][2] + v[i][3] * v[i][3];
#pragma unroll
        for (int o = 32; o >= 1; o >>= 1) ss += __shfl_xor(ss, o);
        const float rstd = rsqrtf(ss * (1.0f / D) + RMS_EPS);
        if (final_out) {
            float* dst = p.out + (size_t)row * D;
#pragma unroll
            for (int i = 0; i < 4; ++i) *(f32x4*)(dst + i * 256 + lane * 4) = v[i] * rstd * g[i];
        } else {
            bf16_t* dst = p.hn + (size_t)row * D;
#pragma unroll
            for (int i = 0; i < 4; ++i) { const f32x4 y = v[i] * rstd * g[i]; u32x2 w; w.x = cvt_pk_bf16(y[0], y[1]); w.y = cvt_pk_bf16(y[2], y[3]); *(u32x2*)(dst + i * 256 + lane * 4) = w; }
        }
#pragma unroll
        for (int i = 0; i < 4; ++i) v[i] = vn[i];
    }
}

__device__ __forceinline__ void attn_phase(const Params& p, unsigned char* shm) {
    const int tid = threadIdx.x, wid = tid >> 6, lane = tid & 63, fr = lane & 15, fq = lane >> 4;
    const int qi = wid & 3, mp = wid >> 2;
    bf16_t* Ksb = (bf16_t*)shm;
    bf16_t* Vsb = (bf16_t*)(shm + 2 * 17408);
    float* Xs = (float*)shm;
    float lam;
    { float s0 = 0.f, s1 = 0.f; for (int d = 0; d < 64; ++d) { s0 += p.da_lambda[d] * p.da_lambda[64 + d]; s1 += p.da_lambda[128 + d] * p.da_lambda[192 + d]; }
      lam = __expf(s0) - __expf(s1) + 0.2f; }
    const float lam_init = 0.2f;
    const float sc2 = 0.125f * 1.44269504089f;
    const int kr0 = tid >> 4, kc0 = (tid & 15) * 8, vr0 = tid >> 3, vc0 = (tid & 7) * 8;
    const int kp0 = 16 * ((kr0 >> 2) & 1) + 4 * (kr0 >> 3) + (kr0 & 3);
    for (int v = blockIdx.x; v < 256; v += gridDim.x) {
        const int xcd = v & 7, slot = v >> 3, bh = xcd * 8 + (slot >> 2), jj = slot & 3, b = bh >> 3, h = bh & 7;
        const int nitems = (jj == 0) ? 5 : 4;
        const bf16_t* kbase = p.kh + ((size_t)(b * 8 + h) * NTOK + kr0) * 128 + kc0;
        const bf16_t* vbase = p.vtc_da + ((size_t)(b * 33) * 1024 + h * 128 + vr0) * 64 + vc0;
        for (int it = 0; it < nitems; ++it) {
            const bool meta = (it == 4);
            const int pp = meta ? 0 : ((it & 1) ? (8 * (it >> 1) + 7 - jj) : (8 * (it >> 1) + jj));
            const int ntiles = meta ? 1 : 2 * pp + 3;
            const int qrowA = (meta ? MX + b * 16 : b * SEQ + 128 * pp) + 16 * qi + fr;
            const int qrowB = meta ? qrowA : qrowA + 64;
            u32x4 kreg[2], vreg[2];
            { kreg[0] = *(const u32x4*)(kbase); kreg[1] = *(const u32x4*)(kbase + 32 * 128);
              vreg[0] = *(const u32x4*)(vbase); vreg[1] = *(const u32x4*)(vbase + 64 * 64); }
            bf16x8 Qf[2][2];
#pragma unroll
            for (int kd = 0; kd < 2; ++kd) { Qf[0][kd] = *(const bf16x8*)(p.qd + (size_t)qrowA * 1024 + h * 128 + mp * 64 + kd * 32 + fq * 8);
                                             Qf[1][kd] = *(const bf16x8*)(p.qd + (size_t)qrowB * 1024 + h * 128 + mp * 64 + kd * 32 + fq * 8); }
            f32x4 accO[2][8];
#pragma unroll
            for (int blk = 0; blk < 2; ++blk)
#pragma unroll
                for (int nb = 0; nb < 8; ++nb) accO[blk][nb] = (f32x4){0.f, 0.f, 0.f, 0.f};
            float mrun[2] = {-INFINITY, -INFINITY}, lrun[2] = {0.f, 0.f};
            __syncthreads();
            *(u32x4*)(Ksb + kp0 * 136 + kc0) = kreg[0]; *(u32x4*)(Ksb + (kp0 + 32) * 136 + kc0) = kreg[1];
            *(u32x4*)(Vsb + vr0 * 72 + vc0) = vreg[0]; *(u32x4*)(Vsb + (vr0 + 64) * 72 + vc0) = vreg[1];
            __syncthreads();
            for (int t = 0; t < ntiles; ++t) {
                const bf16_t* Ks = Ksb + (t & 1) * (64 * 136);
                const bf16_t* Vs = Vsb + (t & 1) * (128 * 72);
                if (t + 1 < ntiles) {
                    const bf16_t* kp = kbase + (size_t)(16 + 64 * t) * 128; const bf16_t* vp = vbase + (size_t)(t + 1) * 65536;
                    kreg[0] = *(const u32x4*)(kp); kreg[1] = *(const u32x4*)(kp + 32 * 128);
                    vreg[0] = *(const u32x4*)(vp); vreg[1] = *(const u32x4*)(vp + 64 * 64);
                }
                const bool actA = meta || (t + 1 < ntiles);
                f32x4 s[2][2][2];
                __builtin_amdgcn_s_setprio(1);
#pragma unroll
                for (int ks = 0; ks < 2; ++ks)
#pragma unroll
                    for (int a = 0; a < 2; ++a) {
                        f32x4 zA = (f32x4){0.f, 0.f, 0.f, 0.f}, zB = (f32x4){0.f, 0.f, 0.f, 0.f};
#pragma unroll
                        for (int kd = 0; kd < 2; ++kd) { const bf16x8 kf = *(const bf16x8*)(Ks + (32 * ks + 16 * a + fr) * 136 + mp * 64 + kd * 32 + fq * 8);
                            zA = __builtin_amdgcn_mfma_f32_16x16x32_bf16(kf, Qf[0][kd], zA, 0, 0, 0); zB = __builtin_amdgcn_mfma_f32_16x16x32_bf16(kf, Qf[1][kd], zB, 0, 0, 0); }
                        s[0][ks][a] = zA; s[1][ks][a] = zB;
                    }
                __builtin_amdgcn_s_setprio(0);
                if (t == 0) {
#pragma unroll
                    for (int blk = 0; blk < 2; ++blk)
#pragma unroll
                        for (int ks = 0; ks < 2; ++ks)
#pragma unroll
                            for (int a = 0; a < 2; ++a)
#pragma unroll
                                for (int j = 0; j < 4; ++j) if (32 * ks + 8 * fq + 4 * a + j >= 16) s[blk][ks][a][j] = -INFINITY;
                }
                bf16x8 Pf[2][2]; float alpha[2];
#pragma unroll
                for (int blk = 0; blk < 2; ++blk) {
                    float tm = -INFINITY;
#pragma unroll
                    for (int ks = 0; ks < 2; ++ks)
#pragma unroll
                        for (int a = 0; a < 2; ++a)
#pragma unroll
                            for (int j = 0; j < 4; ++j) tm = fmaxf(tm, s[blk][ks][a][j]);
                    tm = fmaxf(tm, __shfl_xor(tm, 16)); tm = fmaxf(tm, __shfl_xor(tm, 32));
                    const float mnew = fmaxf(mrun[blk], tm * sc2);
                    alpha[blk] = __builtin_amdgcn_exp2f(mrun[blk] - mnew);
                    float ps = 0.f;
#pragma unroll
                    for (int ks = 0; ks < 2; ++ks) {
                        float e[8];
#pragma unroll
                        for (int a = 0; a < 2; ++a)
#pragma unroll
                            for (int j = 0; j < 4; ++j) { e[4 * a + j] = __builtin_amdgcn_exp2f(__builtin_fmaf(s[blk][ks][a][j], sc2, -mnew)); ps += e[4 * a + j]; }
                        u32x4 w; w.x = cvt_pk_bf16(e[0], e[1]); w.y = cvt_pk_bf16(e[2], e[3]); w.z = cvt_pk_bf16(e[4], e[5]); w.w = cvt_pk_bf16(e[6], e[7]);
                        Pf[blk][ks] = __builtin_bit_cast(bf16x8, w);
                    }
                    if (blk == 1 || actA) { mrun[blk] = mnew; lrun[blk] = lrun[blk] * alpha[blk] + ps; }
                }
                __builtin_amdgcn_s_setprio(1);
                if (actA) {
#pragma unroll
                    for (int nb = 0; nb < 8; ++nb) {
                        f32x4 oA = accO[0][nb] * alpha[0], oB = accO[1][nb] * alpha[1];
#pragma unroll
                        for (int ks = 0; ks < 2; ++ks) { const bf16x8 vf = *(const bf16x8*)(Vs + (nb * 16 + fr) * 72 + ks * 32 + fq * 8);
                            oA = __builtin_amdgcn_mfma_f32_16x16x32_bf16(vf, Pf[0][ks], oA, 0, 0, 0); oB = __builtin_amdgcn_mfma_f32_16x16x32_bf16(vf, Pf[1][ks], oB, 0, 0, 0); }
                        accO[0][nb] = oA; accO[1][nb] = oB;
                    }
                } else {
#pragma unroll
                    for (int nb = 0; nb < 8; ++nb) {
                        f32x4 oB = accO[1][nb] * alpha[1];
#pragma unroll
                        for (int ks = 0; ks < 2; ++ks) { const bf16x8 vf = *(const bf16x8*)(Vs + (nb * 16 + fr) * 72 + ks * 32 + fq * 8); oB = __builtin_amdgcn_mfma_f32_16x16x32_bf16(vf, Pf[1][ks], oB, 0, 0, 0); }
                        accO[1][nb] = oB;
                    }
                }
                __builtin_amdgcn_s_setprio(0);
                if (t + 1 < ntiles) {
                    bf16_t* Kn = Ksb + ((t + 1) & 1) * (64 * 136); bf16_t* Vn = Vsb + ((t + 1) & 1) * (128 * 72);
                    *(u32x4*)(Kn + kp0 * 136 + kc0) = kreg[0]; *(u32x4*)(Kn + (kp0 + 32) * 136 + kc0) = kreg[1];
                    *(u32x4*)(Vn + vr0 * 72 + vc0) = vreg[0]; *(u32x4*)(Vn + (vr0 + 64) * 72 + vc0) = vreg[1];
                }
                __syncthreads();
            }
            float inv[2];
#pragma unroll
            for (int blk = 0; blk < 2; ++blk) { float l = lrun[blk]; l += __shfl_xor(l, 16); l += __shfl_xor(l, 32); inv[blk] = 1.0f / l; }
            if (mp == 1) {
#pragma unroll
                for (int blk = 0; blk < 2; ++blk)
#pragma unroll
                    for (int nb = 0; nb < 8; ++nb) *(f32x4*)(Xs + ((blk * 4 + qi) * 16 + fr) * 132 + nb * 16 + fq * 4) = accO[blk][nb] * inv[blk];
            }
            __syncthreads();
            if (mp == 0) {
#pragma unroll
                for (int blk = 0; blk < 2; ++blk) {
                    if (meta && (blk == 1 || qi != 0)) continue;
                    float ss = 0.f;
#pragma unroll
                    for (int nb = 0; nb < 8; ++nb) { const f32x4 o2 = *(const f32x4*)(Xs + ((blk * 4 + qi) * 16 + fr) * 132 + nb * 16 + fq * 4); const f32x4 o = accO[blk][nb] * inv[blk] - lam * o2; accO[blk][nb] = o; ss += o[0] * o[0] + o[1] * o[1] + o[2] * o[2] + o[3] * o[3]; }
                    ss += __shfl_xor(ss, 16); ss += __shfl_xor(ss, 32);
                    const float rs = rsqrtf(ss * (1.0f / 128.0f) + RMS_EPS) * (1.0f - lam_init);
                    bf16_t* dst = p.qd + (size_t)(blk ? qrowB : qrowA) * D + h * 128 + fq * 4;
#pragma unroll
                    for (int nb = 0; nb < 8; ++nb) { const f32x4 gg = *(const f32x4*)(p.da_subln + nb * 16 + fq * 4); const f32x4 y = accO[blk][nb] * rs * gg;
                        u32x2 w; w.x = cvt_pk_bf16(y[0], y[1]); w.y = cvt_pk_bf16(y[2], y[3]); *(u32x2*)(dst + nb * 16) = w; }
                }
            }
        }
    }
}

__device__ __forceinline__ void gla_prep_phase(const Params& p, unsigned char* shm) {
    float* gl = (float*)shm;
    bf16_t* kt = (bf16_t*)(shm + 4096);
    const int tid = threadIdx.x;
    float w2[16];
#pragma unroll
    for (int r = 0; r < 16; ++r) w2[r] = p.gla_w_gate2[r * 512 + tid];
    const float bias = p.gla_b_gate2[tid];
    for (int it = blockIdx.x; it < NB * 33; it += gridDim.x) {
        const int b = it < 256 ? (it >> 5) : (it - 256), ch = it < 256 ? 1 + (it & 31) : 0;
        const int item = b * 33 + ch;
        const int row0 = ch == 0 ? MX + b * 16 : b * SEQ + 64 * (ch - 1);
        const int nvalid = ch == 0 ? 16 : 64;
        __syncthreads();
        for (int i = tid; i < 1024; i += 512) gl[i] = p.glr[(size_t)row0 * 16 + i];
        { u32x4 kv[8];
#pragma unroll
          for (int i = 0; i < 8; ++i) { const int ch16 = tid + 512 * i, r = ch16 >> 6, c8 = (ch16 & 63) * 8; const int rr = r < nvalid ? r : nvalid - 1;
              kv[i] = *(const u32x4*)(p.g2 + (size_t)(row0 + rr) * 1536 + c8); }
#pragma unroll
          for (int i = 0; i < 8; ++i) { const int ch16 = tid + 512 * i, r = ch16 >> 6, c8 = (ch16 & 63) * 8; *(u32x4*)(kt + r * 512 + c8) = kv[i]; } }
        __syncthreads();
        float gend = 0.f;
        for (int t = 0; t < nvalid; ++t) {
            float z = bias;
#pragma unroll
            for (int r = 0; r < 16; ++r) z += gl[t * 16 + r] * w2[r];
            gend += (fminf(z, 0.f) - __logf(1.0f + __expf(-fabsf(z)))) * (1.0f / 16.0f);
        }
        p.decay[(size_t)item * 512 + tid] = __expf(gend);
        bf16_t* dst = p.kdecT + ((size_t)item * 512 + tid) * 64;
        float G = 0.f;
        for (int t8 = 0; t8 < 8; ++t8) {
            float kd[8];
#pragma unroll
            for (int q = 0; q < 8; ++q) {
                const int t = t8 * 8 + q;
                float val = 0.f;
                if (t < nvalid) {
                    float z = bias;
#pragma unroll
                    for (int r = 0; r < 16; ++r) z += gl[t * 16 + r] * w2[r];
                    G += (fminf(z, 0.f) - __logf(1.0f + __expf(-fabsf(z)))) * (1.0f / 16.0f);
                    val = bf2f(kt[t * 512 + tid]) * __expf(gend - G);
                }
                kd[q] = val;
            }
            u32x4 w; w.x = cvt_pk_bf16(kd[0], kd[1]); w.y = cvt_pk_bf16(kd[2], kd[3]); w.z = cvt_pk_bf16(kd[4], kd[5]); w.w = cvt_pk_bf16(kd[6], kd[7]);
            *(u32x4*)(dst + t8 * 8) = w;
        }
    }
}

struct ScanOps { bf16x8 Af[2], Bf[2][2], Qf[4]; f32x4 dc; };
__device__ __forceinline__ void scan_load(ScanOps& o, const Params& p, int b, int h, int dvs, int ch, int wid, int fr, int fq) {
    const int item = b * 33 + ch;
    const int tok0 = ch == 0 ? 0 : 16 + 64 * (ch - 1);
    const int tb = wid >> 1;
#pragma unroll
    for (int ks = 0; ks < 2; ++ks) {
        o.Af[ks] = *(const bf16x8*)(p.kdecT + ((size_t)item * 512 + h * 128 + wid * 16 + fr) * 64 + ks * 32 + fq * 8);
#pragma unroll
        for (int vb = 0; vb < 2; ++vb) o.Bf[vb][ks] = *(const bf16x8*)(p.vtc_gla + ((size_t)item * 1024 + h * 256 + dvs * 32 + vb * 16 + fr) * 64 + ks * 32 + fq * 8);
    }
    o.dc = *(const f32x4*)(p.decay + (size_t)item * 512 + h * 128 + wid * 16 + fq * 4);
#pragma unroll
    for (int kc = 0; kc < 4; ++kc) o.Qf[kc] = *(const bf16x8*)(p.qh + ((size_t)(b * 4 + h) * NTOK + tok0 + tb * 16 + fr) * 128 + kc * 32 + fq * 8);
}
__device__ __forceinline__ void gla_scan_phase(const Params& p, unsigned char* shm) {
    const int tid = threadIdx.x, wid = tid >> 6, lane = tid & 63, fr = lane & 15, fq = lane >> 4;
    bf16_t* Ssb = (bf16_t*)shm;
    const float qscale = 0.08838834764831845f;
    for (int wg = blockIdx.x; wg < 256; wg += gridDim.x) {
        const int xcd_ = wg & 7, slot_ = wg >> 3, bh_ = xcd_ * 4 + (slot_ >> 3);
        const int b = bh_ >> 2, h = bh_ & 3, dvs = slot_ & 7;
        f32x4 accS[2] = {(f32x4){0.f, 0.f, 0.f, 0.f}, (f32x4){0.f, 0.f, 0.f, 0.f}};
        const int tb = wid >> 1, vb2 = wid & 1;
        ScanOps r0, r1, r2, r3;
        scan_load(r0, p, b, h, dvs, 0, wid, fr, fq);
        scan_load(r1, p, b, h, dvs, 1, wid, fr, fq);
        scan_load(r2, p, b, h, dvs, 2, wid, fr, fq);
        __syncthreads();
#define SCAN_STEP(CUR, NXT, CH) do { const int ch_ = (CH); \
            const int row0 = ch_ == 0 ? MX + b * 16 : b * SEQ + 64 * (ch_ - 1); const int nvalid = ch_ == 0 ? 16 : 64; \
            bf16_t* Ss = Ssb + (ch_ & 1) * (32 * 136); \
            if (ch_ + 3 < 33) scan_load(NXT, p, b, h, dvs, ch_ + 3, wid, fr, fq); \
            _Pragma("unroll") for (int vb = 0; vb < 2; ++vb) { \
                f32x4 s = accS[vb] * CUR.dc; \
                _Pragma("unroll") for (int ks = 0; ks < 2; ++ks) s = __builtin_amdgcn_mfma_f32_16x16x32_bf16(CUR.Af[ks], CUR.Bf[vb][ks], s, 0, 0, 0); \
                accS[vb] = s; \
                u32x2 w; w.x = cvt_pk_bf16(s[0], s[1]); w.y = cvt_pk_bf16(s[2], s[3]); \
                *(u32x2*)(Ss + (vb * 16 + fr) * 136 + wid * 16 + fq * 4) = w; } \
            asm volatile("s_waitcnt lgkmcnt(0)" ::: "memory"); __builtin_amdgcn_s_barrier(); asm volatile("" ::: "memory");     \
            f32x4 o = (f32x4){0.f, 0.f, 0.f, 0.f}; \
            _Pragma("unroll") for (int kc = 0; kc < 4; ++kc) { const bf16x8 sf = *(const bf16x8*)(Ss + (vb2 * 16 + fr) * 136 + kc * 32 + fq * 8); o = __builtin_amdgcn_mfma_f32_16x16x32_bf16(sf, CUR.Qf[kc], o, 0, 0, 0); } \
            if (tb * 16 + fr < nvalid) { o = o * qscale; u32x2 w; w.x = cvt_pk_bf16(o[0], o[1]); w.y = cvt_pk_bf16(o[2], o[3]); \
                *(u32x2*)(p.hn + (size_t)(row0 + tb * 16 + fr) * D + h * 256 + dvs * 32 + vb2 * 16 + fq * 4) = w; } \
        } while (0)
        for (int c4 = 0; c4 < 32; c4 += 4) {
            SCAN_STEP(r0, r3, c4); SCAN_STEP(r1, r0, c4 + 1); SCAN_STEP(r2, r1, c4 + 2); SCAN_STEP(r3, r2, c4 + 3);
        }
        SCAN_STEP(r0, r3, 32);
#undef SCAN_STEP
        __syncthreads();
    }
}

__device__ __forceinline__ void gla_post_phase(const Params& p) {
    const int wid = threadIdx.x >> 6, lane = threadIdx.x & 63, stride = gridDim.x * 8;
    const f32x4 g = *(const f32x4*)(p.gla_norm + lane * 4);
    int row = blockIdx.x * 8 + wid;
    u32x2 ow[4], gw[4], own[4], gwn[4];
    if (row < MTOT) {
#pragma unroll
        for (int h = 0; h < 4; ++h) { ow[h] = *(const u32x2*)(p.hn + (size_t)row * D + h * 256 + lane * 4); gw[h] = *(const u32x2*)(p.g2 + (size_t)row * 1536 + 512 + h * 256 + lane * 4); } }
    for (; row < MTOT; row += stride) {
        const int nrow = row + stride;
        if (nrow < MTOT) {
#pragma unroll
            for (int h = 0; h < 4; ++h) { own[h] = *(const u32x2*)(p.hn + (size_t)nrow * D + h * 256 + lane * 4); gwn[h] = *(const u32x2*)(p.g2 + (size_t)nrow * 1536 + 512 + h * 256 + lane * 4); } }
#pragma unroll
        for (int h = 0; h < 4; ++h) {
            const float o0 = bflo(ow[h].x), o1 = bfhi(ow[h].x), o2 = bflo(ow[h].y), o3 = bfhi(ow[h].y);
            float ss = o0 * o0 + o1 * o1 + o2 * o2 + o3 * o3;
#pragma unroll
            for (int o = 32; o >= 1; o >>= 1) ss += __shfl_xor(ss, o);
            const float rs = rsqrtf(ss * (1.0f / 256.0f) + RMS_EPS);
            const float y0 = o0 * rs * g[0] * silu_f(bflo(gw[h].x)), y1 = o1 * rs * g[1] * silu_f(bfhi(gw[h].x)), y2 = o2 * rs * g[2] * silu_f(bflo(gw[h].y)), y3 = o3 * rs * g[3] * silu_f(bfhi(gw[h].y));
            u32x2 w; w.x = cvt_pk_bf16(y0, y1); w.y = cvt_pk_bf16(y2, y3);
            *(u32x2*)(p.g2 + (size_t)row * 1536 + 512 + h * 256 + lane * 4) = w;
        }
#pragma unroll
        for (int h = 0; h < 4; ++h) { ow[h] = own[h]; gw[h] = gwn[h]; }
    }
}

template <int NBLK, bool TRANS_OUT, class Fin>
__device__ __forceinline__ void small_gemm_item(unsigned char* shm, const bf16_t* A, int lda, const bf16_t* Bt0, const bf16_t* Bt1, int K, const Fin& fin) {
    const int tid = threadIdx.x, wid = tid >> 6, lane = tid & 63, fr = lane & 15, fq = lane >> 4;
    const int kw = K >> 3, k0 = wid * kw;
    f32x4 acc[8][NBLK];
#pragma unroll
    for (int rb = 0; rb < 8; ++rb)
#pragma unroll
        for (int cb = 0; cb < NBLK; ++cb) acc[rb][cb] = (f32x4){0.f, 0.f, 0.f, 0.f};
    const bf16_t* ap = A + (size_t)fr * lda + k0 + fq * 8;
    const bf16_t* bp0 = Bt0 + (size_t)fr * K + k0 + fq * 8;
    const bf16_t* bp1 = Bt1 + (size_t)fr * K + k0 + fq * 8;
    bf16x8 bf[NBLK], af[8], bfn[NBLK], afn[8];
    bf[0] = *(const bf16x8*)(bp0);
    if (NBLK > 1) bf[NBLK - 1] = *(const bf16x8*)(bp1);
#pragma unroll
    for (int rb = 0; rb < 8; ++rb) af[rb] = *(const bf16x8*)(ap + (size_t)rb * 16 * lda);
#pragma unroll 1
    for (int k = 0; k < kw; k += 32) {
        const int kn = (k + 32 < kw) ? k + 32 : k;
        bfn[0] = *(const bf16x8*)(bp0 + kn);
        if (NBLK > 1) bfn[NBLK - 1] = *(const bf16x8*)(bp1 + kn);
#pragma unroll
        for (int rb = 0; rb < 8; ++rb) afn[rb] = *(const bf16x8*)(ap + (size_t)rb * 16 * lda + kn);
#pragma unroll
        for (int rb = 0; rb < 8; ++rb)
#pragma unroll
            for (int cb = 0; cb < NBLK; ++cb)
                acc[rb][cb] = TRANS_OUT ? __builtin_amdgcn_mfma_f32_16x16x32_bf16(af[rb], bf[cb], acc[rb][cb], 0, 0, 0)
                                        : __builtin_amdgcn_mfma_f32_16x16x32_bf16(bf[cb], af[rb], acc[rb][cb], 0, 0, 0);
#pragma unroll
        for (int cb = 0; cb < NBLK; ++cb) bf[cb] = bfn[cb];
#pragma unroll
        for (int rb = 0; rb < 8; ++rb) af[rb] = afn[rb];
    }
    f32x4* part = (f32x4*)shm;
    __syncthreads();
#pragma unroll
    for (int rb = 0; rb < 8; ++rb)
#pragma unroll
        for (int cb = 0; cb < NBLK; ++cb) part[((wid * 8 + rb) * NBLK + cb) * 64 + lane] = acc[rb][cb];
    __syncthreads();
    f32x4 sum[NBLK];
#pragma unroll
    for (int cb = 0; cb < NBLK; ++cb) {
        f32x4 s = (f32x4){0.f, 0.f, 0.f, 0.f};
#pragma unroll
        for (int w = 0; w < 8; ++w) s += part[((w * 8 + wid) * NBLK + cb) * 64 + lane];
        sum[cb] = s;
    }
    fin(wid, sum, fr, fq);
    __syncthreads();
}
__device__ __forceinline__ u32x2 pack4(const f32x4 v) { u32x2 w; w.x = cvt_pk_bf16(v[0], v[1]); w.y = cvt_pk_bf16(v[2], v[3]); return w; }

#define SMALL_ITEMS(i, n) for (int i = (int)gridDim.x - 1 - (int)blockIdx.x; i < (n); i += (int)gridDim.x)

__device__ __forceinline__ void ph_ffn_in(const Params& p, unsigned char* shm, int widx) {
    const bf16_t* W = p.w_ffn_in[widx];
    SMALL_ITEMS(i, DFF / 16) {
        const int pn = (16 * i) >> 7, within = (16 * i) & 127;
        bf16_t* O = p.big;
        auto fin = [=](int rb, const f32x4 (&s)[2], int fr, int fq) {
            f32x4 y; for (int j = 0; j < 4; ++j) y[j] = silu_f(s[0][j]) * s[1][j];
            *(u32x2*)(O + (size_t)(MX + rb * 16 + fr) * DFF + 16 * i + fq * 4) = pack4(y); };
        small_gemm_item<2, false>(shm, p.hn + (size_t)MX * D, D, W + (size_t)(256 * pn + within) * D, W + (size_t)(256 * pn + 128 + within) * D, D, fin);
    }
    pg8::StaticOrder S; pg8::Gemm g{p.hn, W, MX, 2 * DFF, D, D}; S.init(g.M, g.N, gridDim.x, blockIdx.x);
    EpiSwiGLU E{p.big};
    if (S.split_tail()) {
        S.mode = 1; pg8::gemm_phase((LAS unsigned char*)shm, g, S, E);
        S.mode = 2;
        if (blockIdx.x & 1) pg8::gemm_phase<EpiSwiGLU, 2>((LAS unsigned char*)shm, g, S, E);
        else pg8::gemm_phase<EpiSwiGLU, 1>((LAS unsigned char*)shm, g, S, E);
    } else pg8::gemm_phase((LAS unsigned char*)shm, g, S, E);
}
template <bool HALFS, bool FINAL, bool BASEF32>
__device__ __forceinline__ void ph_resid(const Params& p, unsigned char* shm, const bf16_t* A, int lda, const bf16_t* Bt, int K, const float* base_x, const float* gain, int inst) {
    constexpr float scale = HALFS ? 0.5f : 1.0f;
    if (!FINAL) {
        unsigned* cmeta = p.xcnt + 6 * 64 * 64 + inst * 64;
        SMALL_ITEMS(i, D / 32) {
            float* H = p.hmeta;
            auto fin = [=](int rb, const f32x4 (&s)[2], int fr, int fq) {
#pragma unroll
                for (int cb = 0; cb < 2; ++cb) { float* hp = H + (size_t)(rb * 16 + fr) * D + 32 * i + cb * 16 + fq * 4; *(f32x4*)hp = *(const f32x4*)hp + scale * s[cb]; } };
            small_gemm_item<2, false>(shm, A + (size_t)MX * lda, lda, Bt + (size_t)(32 * i) * K, Bt + (size_t)(32 * i + 16) * K, K, fin);
            asm volatile("s_waitcnt vmcnt(0)" ::: "memory");
            __syncthreads();
            LAS unsigned* flag = (LAS unsigned*)shm;
            if (threadIdx.x == 0) {
                __builtin_amdgcn_fence(__ATOMIC_RELEASE, "agent");
                asm volatile("s_waitcnt vmcnt(0)" ::: "memory");
                const unsigned old = __hip_atomic_fetch_add(cmeta, 1u, __ATOMIC_RELAXED, __HIP_MEMORY_SCOPE_AGENT);
                const unsigned last = (old == (unsigned)(D / 32 - 1)) ? 1u : 0u;
                if (last) { __builtin_amdgcn_fence(__ATOMIC_ACQUIRE, "agent"); asm volatile("s_waitcnt vmcnt(0)" ::: "memory"); }
                *flag = last;
            }
            __syncthreads();
            if (*flag) {
                const int wid = threadIdx.x >> 6, lane = threadIdx.x & 63;
                f32x4 g[4];
#pragma unroll
                for (int q = 0; q < 4; ++q) g[q] = *(const f32x4*)(gain + q * 256 + lane * 4);
                f32x4 v[4], vn[4];
                { const float* s = p.hmeta + (size_t)(wid * 16) * D;
#pragma unroll
                  for (int q = 0; q < 4; ++q) v[q] = *(const f32x4*)(s + q * 256 + lane * 4); }
                for (int rr = 0; rr < 16; ++rr) {
                    const int row = wid * 16 + rr;
                    { const float* s = p.hmeta + (size_t)(rr < 15 ? row + 1 : row) * D;
#pragma unroll
                      for (int q = 0; q < 4; ++q) vn[q] = *(const f32x4*)(s + q * 256 + lane * 4); }
                    float ss = 0.f;
#pragma unroll
                    for (int q = 0; q < 4; ++q) ss += v[q][0] * v[q][0] + v[q][1] * v[q][1] + v[q][2] * v[q][2] + v[q][3] * v[q][3];
#pragma unroll
                    for (int o = 32; o >= 1; o >>= 1) ss += __shfl_xor(ss, o);
                    const float rstd = rsqrtf(ss * (1.0f / D) + RMS_EPS);
                    bf16_t* dst = p.hn + (size_t)(MX + row) * D;
#pragma unroll
                    for (int q = 0; q < 4; ++q) { const f32x4 y = v[q] * rstd * g[q]; u32x2 w; w.x = cvt_pk_bf16(y[0], y[1]); w.y = cvt_pk_bf16(y[2], y[3]); *(u32x2*)(dst + q * 256 + lane * 4) = w; }
#pragma unroll
                    for (int q = 0; q < 4; ++q) v[q] = vn[q];
                }
            }
            __syncthreads();
        }
    }
    pg8::StaticOrder S; pg8::Gemm g{A, Bt, MX, D, K, lda}; S.init(g.M, g.N, gridDim.x, blockIdx.x);
    EpiResidNorm<HALFS, FINAL, BASEF32> E{base_x, p.out, p.hn, gain, p.xbuf + (size_t)inst * 64 * 256 * 4, p.xcnt + inst * 64 * 64};
    pg8::gemm_phase((LAS unsigned char*)shm, g, S, E);
}
__device__ __forceinline__ void ph_da_qk(const Params& p, unsigned char* shm) {
    const bf16_t* Bt = p.w_da_qk; const DstDaQK dst{p.qd, p.kh};
    SMALL_ITEMS(i, 2048 / 32) {
        auto fin = [=](int rb, const f32x4 (&s)[2], int fr, int fq) {
#pragma unroll
            for (int cb = 0; cb < 2; ++cb) { const int c = 32 * i + cb * 16 + fq * 4;
                bf16_t* d = c < 1024 ? dst.Qd + (size_t)(MX + rb * 16 + fr) * 1024 + c : dst.Kh + ((size_t)(rb * 8 + ((c - 1024) >> 7)) * NTOK + fr) * 128 + (c & 127);
                *(u32x2*)d = pack4(s[cb]); } };
        small_gemm_item<2, false>(shm, p.hn + (size_t)MX * D, D, Bt + (size_t)(32 * i) * D, Bt + (size_t)(32 * i + 16) * D, D, fin);
    }
    pg8::StaticOrder S; pg8::Gemm g{p.hn, Bt, MX, 2048, D, D}; S.init(g.M, g.N, gridDim.x, blockIdx.x);
    EpiBf16T<DstDaQK> E{dst}; pg8::gemm_phase((LAS unsigned char*)shm, g, S, E);
}
__device__ __forceinline__ void ph_gla_main(const Params& p, unsigned char* shm) {
    const bf16_t* Bt = p.w_gla_main; const DstGlaMain dst{p.qh, p.g2};
    SMALL_ITEMS(i, 2048 / 32) {
        auto fin = [=](int rb, const f32x4 (&s)[2], int fr, int fq) {
#pragma unroll
            for (int cb = 0; cb < 2; ++cb) { const int c = 32 * i + cb * 16 + fq * 4;
                bf16_t* d = c < 512 ? dst.qh + ((size_t)(rb * 4 + (c >> 7)) * NTOK + fr) * 128 + (c & 127) : dst.g2 + (size_t)(MX + rb * 16 + fr) * 1536 + (c - 512);
                *(u32x2*)d = pack4(s[cb]); } };
        small_gemm_item<2, false>(shm, p.hn + (size_t)MX * D, D, Bt + (size_t)(32 * i) * D, Bt + (size_t)(32 * i + 16) * D, D, fin);
    }
    pg8::StaticOrder S; pg8::Gemm g{p.hn, Bt, MX, 2048, D, D}; S.init(g.M, g.N, gridDim.x, blockIdx.x);
    EpiBf16T<DstGlaMain> E{dst}; pg8::gemm_phase((LAS unsigned char*)shm, g, S, E);
}
__device__ __forceinline__ void ph_vt(unsigned char* shm, const bf16_t* Wv, const bf16_t* hn, bf16_t* vtc) {
    SMALL_ITEMS(i, 1024 / 32) {
        auto fin = [=](int rb, const f32x4 (&s)[2], int fr, int fq) {
#pragma unroll
            for (int cb = 0; cb < 2; ++cb) *(u32x2*)(vtc + ((size_t)(rb * 33) * 1024 + 32 * i + cb * 16 + fr) * 64 + fq * 4) = pack4(s[cb]); };
        small_gemm_item<2, true>(shm, hn + (size_t)MX * D, D, Wv + (size_t)(32 * i) * D, Wv + (size_t)(32 * i + 16) * D, D, fin);
    }
    pg8::StaticOrder S; pg8::Gemm g{Wv, hn, 1024, MX, D, D}; S.init(g.M, g.N, gridDim.x, blockIdx.x);
    EpiBf16T<DstVTc> E{DstVTc{vtc}}; pg8::gemm_phase((LAS unsigned char*)shm, g, S, E);
}
__device__ __forceinline__ void ph_glr(const Params& p, unsigned char* shm) {
    SMALL_ITEMS(i, MTOT / 128) {
        float* G = p.glr;
        auto fin = [=](int rb, const f32x4 (&s)[1], int fr, int fq) { *(f32x4*)(G + (size_t)(128 * i + rb * 16 + fr) * 16 + fq * 4) = s[0]; };
        const bf16_t* Wg = p.w_gla_main + (size_t)2048 * D;
        small_gemm_item<1, false>(shm, p.hn + (size_t)(128 * i) * D, D, Wg, Wg, D, fin);
    }
}

constexpr int NPHASES = 24;
#define XB_TMO      128
#define XB_XCNT(j)  (256  + 64 * (j))
#define XB_XSUB(j)  (1280 + 64 * (j))
#define XB_XGEN(j)  (2304 + 64 * (j))
#define XB_TOP      3328
#define XB_TOPGEN   3392
#define XCD_BAR_WORDS 3456
#define XB_SPIN_CAP (1u << 18)
__device__ __forceinline__ unsigned xb_ld(unsigned* p)              { return __hip_atomic_load(p, __ATOMIC_RELAXED, __HIP_MEMORY_SCOPE_AGENT); }
__device__ __forceinline__ unsigned xb_add(unsigned* p, unsigned v) { return __hip_atomic_fetch_add(p, v, __ATOMIC_RELAXED, __HIP_MEMORY_SCOPE_AGENT); }
__device__ __forceinline__ unsigned xb_xcc_id() { return (unsigned)__builtin_amdgcn_s_getreg((3 << 11) | 20) & 0xFu; }
#define XB_SPIN(cond, bar) do { unsigned _sp = 0; while (cond) { __builtin_amdgcn_s_sleep(1); \
    if ((++_sp & 255u) == 0u) { if (xb_ld(&(bar)[XB_TMO])) break; if (_sp > XB_SPIN_CAP) { atomicAdd(&(bar)[XB_TMO], 1u); break; } } } } while (0)
struct XcdBarrier { unsigned* bar; unsigned x; volatile LAS unsigned* st; };
__device__ __forceinline__ XcdBarrier xcd_barrier_post(unsigned* bar, volatile LAS unsigned* st) {
    XcdBarrier b; b.bar = bar; b.x = xb_xcc_id(); b.st = st;
    if (threadIdx.x == 0) (void)xb_add(&bar[XB_XCNT(b.x)], 1u);
    return b;
}
__device__ __forceinline__ void xcd_barrier_complete(unsigned* bar, unsigned x, unsigned& nloc, unsigned& nx) {
    const unsigned G = gridDim.x * gridDim.y * gridDim.z;
    unsigned sum, cnt, mine, sp = 0u;
    for (;;) {
        sum = 0u; cnt = 0u; mine = 0u;
#pragma unroll
        for (unsigned j = 0; j < 16; ++j) { const unsigned c = xb_ld(&bar[XB_XCNT(j)]); sum += c; cnt += (c > 0u) ? 1u : 0u; mine = (j == x) ? c : mine; }
        if (sum == G) break;
        __builtin_amdgcn_s_sleep(1);
        if ((++sp & 255u) == 0u) { if (xb_ld(&bar[XB_TMO])) break; if (sp > XB_SPIN_CAP) { atomicAdd(&bar[XB_TMO], 1u); break; } }
    }
    nloc = mine > 0u ? mine : 1u; nx = cnt > 0u ? cnt : 1u;
}
__device__ __attribute__((noinline)) void xcd_barrier(unsigned* barp) {
    extern __shared__ __attribute__((aligned(16))) unsigned char shm_xb[];
    XcdBarrier b; b.bar = barp; b.x = xb_xcc_id(); b.st = (volatile LAS unsigned*)((LAS unsigned char*)shm_xb + LDS_BYTES);
    asm volatile("s_waitcnt vmcnt(0)" ::: "memory");
    __syncthreads();
    if (threadIdx.x == 0) {
        unsigned* bar = b.bar;
        __builtin_amdgcn_s_waitcnt(0);
        unsigned nloc = b.st[0], nx = b.st[1];
        if (nloc == 0u) { xcd_barrier_complete(bar, b.x, nloc, nx); b.st[0] = nloc; b.st[1] = nx; }
        const unsigned old = xb_add(&bar[XB_XSUB(b.x)], 1u);
        const unsigned gen = old / nloc;
        if (old + 1u == (gen + 1u) * nloc) {
            __builtin_amdgcn_fence(__ATOMIC_RELEASE, "agent");
            asm volatile("s_waitcnt vmcnt(0)" ::: "memory");
            const unsigned og = xb_add(&bar[XB_TOP], 1u);
            const unsigned tg = og / nx;
            if (og + 1u == (tg + 1u) * nx) xb_add(&bar[XB_TOPGEN], 1u);
            else XB_SPIN(xb_ld(&bar[XB_TOPGEN]) == tg, bar);
            __builtin_amdgcn_fence(__ATOMIC_ACQUIRE, "agent");
            xb_add(&bar[XB_XGEN(b.x)], 1u);
            asm volatile("s_waitcnt vmcnt(0)" ::: "memory");
        } else {
            XB_SPIN(xb_ld(&bar[XB_XGEN(b.x)]) == gen, bar);
            __builtin_amdgcn_fence(__ATOMIC_ACQUIRE, "agent");
            asm volatile("s_waitcnt vmcnt(0)" ::: "memory");
        }
    }
    __syncthreads();
}
#ifndef PROBE_MASK
#define PROBE_MASK 0u
#endif
#define RUN(idx, ...) if (p.ph_lo <= (idx) && (idx) < p.ph_hi) { if ((PROBE_MASK >> (idx)) & 1u) { __VA_ARGS__; xcd_barrier(p.bar); } __VA_ARGS__; if ((idx) < 22 && (idx) + 1 < p.ph_hi) xcd_barrier(p.bar); }

__global__ void __launch_bounds__(512, 2) fwd_megakernel(const Params p) {
    extern __shared__ __attribute__((aligned(16))) unsigned char shm[];
    cg::grid_group grid = cg::this_grid();
    if (p.ph_hi > 1000) grid.sync();
    volatile LAS unsigned* xst = (volatile LAS unsigned*)((LAS unsigned char*)shm + LDS_BYTES);
    if (threadIdx.x == 0) { xst[0] = 0u; xst[1] = 0u; }
    __syncthreads();
    (void)xcd_barrier_post(p.bar, xst);
    RUN(0, prep_phase(p, shm); norm_phase(p, p.x, p.ffn1_norm, false, true))
    RUN(2, ph_ffn_in(p, shm, 0))
    RUN(3, (ph_resid<true, false, true>(p, shm, p.big, DFF, p.w_ffn_out[0], DFF, p.x, p.mix_norm, 0)))
    RUN(5, ph_da_qk(p, shm); ph_vt(shm, p.w_da_v, p.hn, p.vtc_da))
    RUN(6, attn_phase(p, shm))
    RUN(7, (ph_resid<false, false, false>(p, shm, p.qd, D, p.w_da_out, D, p.out, p.ffn2_norm, 1)))
    RUN(9, ph_ffn_in(p, shm, 1))
    RUN(10, (ph_resid<true, false, false>(p, shm, p.big, DFF, p.w_ffn_out[1], DFF, p.out, p.ffn1_norm + D, 2)))
    RUN(12, ph_ffn_in(p, shm, 2))
    RUN(13, (ph_resid<true, false, false>(p, shm, p.big, DFF, p.w_ffn_out[2], DFF, p.out, p.mix_norm + D, 3)))
    RUN(15, ph_glr(p, shm); ph_gla_main(p, shm); ph_vt(shm, p.w_gla_v, p.hn, p.vtc_gla))
    RUN(16, gla_prep_phase(p, shm))
    RUN(17, gla_scan_phase(p, shm))
    RUN(18, gla_post_phase(p))
    RUN(19, (ph_resid<false, false, false>(p, shm, p.g2 + 512, 1536, p.w_gla_out, D, p.out, p.ffn2_norm + D, 4)))
    RUN(21, ph_ffn_in(p, shm, 3))
    RUN(22, (ph_resid<true, true, false>(p, shm, p.big, DFF, p.w_ffn_out[3], DFF, p.out, p.final_norm, 5)))
}

#ifndef N_LAUNCH_MODE
#define N_LAUNCH_MODE 0
#endif

extern "C" void kernel_launch(void* const* d_in, const int* in_sizes, int n_in, void* d_out, int out_size, void* d_ws, size_t ws_size, hipStream_t stream) {
    (void)in_sizes; (void)n_in; (void)out_size;
    Params p; memset(&p, 0, sizeof(p));
    const float* x = (const float*)d_in[0];
    p.x = x; p.meta = (const float*)d_in[1]; p.ffn1_norm = (const float*)d_in[2];
    const float* ffn1_w_in = (const float*)d_in[3]; const float* ffn1_w_out = (const float*)d_in[4];
    p.mix_norm = (const float*)d_in[5]; p.ffn2_norm = (const float*)d_in[6];
    const float* ffn2_w_in = (const float*)d_in[7]; const float* ffn2_w_out = (const float*)d_in[8];
    const float* da_w_in = (const float*)d_in[9]; p.da_lambda = (const float*)d_in[10]; p.da_subln = (const float*)d_in[11];
    const float* da_w_out = (const float*)d_in[12]; const float* gla_w_in = (const float*)d_in[13];
    p.gla_w_gate2 = (const float*)d_in[14]; p.gla_b_gate2 = (const float*)d_in[15]; p.gla_norm = (const float*)d_in[16];
    const float* gla_w_out = (const float*)d_in[17]; p.final_norm = (const float*)d_in[18];
    p.out = (float*)d_out;

    char* ws = (char*)d_ws; size_t off = 0;
    auto take = [&](size_t bytes) { char* r = ws + off; off += (bytes + 255) & ~(size_t)255; return r; };
    for (int i = 0; i < 4; ++i) p.w_ffn_in[i] = (bf16_t*)take((size_t)2 * DFF * D * 2);
    for (int i = 0; i < 4; ++i) p.w_ffn_out[i] = (bf16_t*)take((size_t)D * DFF * 2);
    p.w_da_qk = (bf16_t*)take((size_t)2048 * D * 2); p.w_da_v = (bf16_t*)take((size_t)1024 * D * 2); p.w_da_out = (bf16_t*)take((size_t)1024 * D * 2);
    p.w_gla_main = (bf16_t*)take((size_t)2304 * D * 2); p.w_gla_v = (bf16_t*)take((size_t)1024 * D * 2); p.w_gla_out = (bf16_t*)take((size_t)1024 * D * 2);
    p.big = (bf16_t*)take((size_t)51314688 * 2);
    p.qd = p.big; p.kh = p.big + (size_t)MP * 1024; p.vtc_da = p.kh + (size_t)64 * NTOK * 128;
    p.g2 = p.big; p.qh = p.big + (size_t)MP * 1536; p.vtc_gla = p.qh + (size_t)32 * NTOK * 128;
    p.hn = (bf16_t*)take((size_t)MP * D * 2);
    p.kdecT = (bf16_t*)take((size_t)NB * 33 * 512 * 64 * 2);
    p.hmeta = (float*)take((size_t)256 * D * 4);
    p.glr = (float*)take((size_t)MP * 16 * 4);
    p.decay = (float*)take((size_t)NB * 33 * 512 * 4);
    p.bar = (unsigned*)take((size_t)(XCD_BAR_WORDS + XCNT_WORDS) * 4); p.xcnt = p.bar + XCD_BAR_WORDS;
    p.xbuf = (float*)take((size_t)6 * 64 * 256 * 4 * 4);
    if (off > ws_size) { fprintf(stderr, "workspace too small: need %zu have %zu\n", off, ws_size); return; }

    int nj = 0, tiles = 0;
    auto add = [&](const float* src, bf16_t* dst, int ldw, int K, int ndst, int col0, int mode, int nvalid) {
        Job& j = p.jobs[nj++]; j.src = src; j.dst = dst; j.ldw = ldw; j.K = K; j.ndst = ndst; j.col0 = col0; j.mode = mode; j.nvalid = nvalid; j.tile0 = tiles; j.pad = 0;
        tiles += (K / 128) * (ndst / 128); };
    add(ffn1_w_in, p.w_ffn_in[0], 2 * DFF, D, 2 * DFF, 0, 1, 2 * DFF);
    add(ffn2_w_in, p.w_ffn_in[1], 2 * DFF, D, 2 * DFF, 0, 1, 2 * DFF);
    add(ffn1_w_in + (size_t)D * 2 * DFF, p.w_ffn_in[2], 2 * DFF, D, 2 * DFF, 0, 1, 2 * DFF);
    add(ffn2_w_in + (size_t)D * 2 * DFF, p.w_ffn_in[3], 2 * DFF, D, 2 * DFF, 0, 1, 2 * DFF);
    add(ffn1_w_out, p.w_ffn_out[0], D, DFF, D, 0, 0, D);
    add(ffn2_w_out, p.w_ffn_out[1], D, DFF, D, 0, 0, D);
    add(ffn1_w_out + (size_t)DFF * D, p.w_ffn_out[2], D, DFF, D, 0, 0, D);
    add(ffn2_w_out + (size_t)DFF * D, p.w_ffn_out[3], D, DFF, D, 0, 0, D);
    add(da_w_in, p.w_da_qk, 3072, D, 2048, 0, 0, 2048);
    add(da_w_in, p.w_da_v, 3072, D, 1024, 2048, 0, 1024);
    add(da_w_out, p.w_da_out, D, D, D, 0, 0, D);
    add(gla_w_in, p.w_gla_main, 3088, D, 1024, 0, 0, 1024);
    add(gla_w_in, p.w_gla_main + (size_t)1024 * D, 3088, D, 1024, 2048, 0, 1024);
    add(gla_w_in, p.w_gla_main + (size_t)2048 * D, 3088, D, 256, 3072, 0, 16);
    add(gla_w_in, p.w_gla_v, 3088, D, 1024, 1024, 0, 1024);
    add(gla_w_out, p.w_gla_out, D, D, D, 0, 0, D);
    p.njobs = nj; p.ntiles_prep = tiles;

    static int grid_blocks = 0;
    if (!grid_blocks) {
        (void)hipFuncSetAttribute((const void*)fwd_megakernel, hipFuncAttributeMaxDynamicSharedMemorySize, LDS_TOTAL);
        int dev = 0, cus = 0, per_cu = 0;
        (void)hipGetDevice(&dev);
        (void)hipDeviceGetAttribute(&cus, hipDeviceAttributeMultiprocessorCount, dev);
        (void)hipOccupancyMaxActiveBlocksPerMultiprocessor(&per_cu, fwd_megakernel, 512, LDS_TOTAL);
        if (per_cu > 1) per_cu = 1;
        grid_blocks = cus * per_cu;
        if (grid_blocks <= 0) grid_blocks = 256;
    }
#if N_LAUNCH_MODE == 1
    for (int ph = 0; ph < NPHASES; ++ph) {
        p.ph_lo = ph; p.ph_hi = ph + 1;
        hipLaunchKernelGGL(fwd_megakernel, dim3(grid_blocks), dim3(512), LDS_TOTAL, stream, p);
    }
#else
    p.ph_lo = 0; p.ph_hi = NPHASES;
    (void)hipMemsetAsync(p.bar, 0, (size_t)XCD_BAR_WORDS * 4, stream);
    void* args[] = {(void*)&p};
    hipError_t e = hipLaunchCooperativeKernel((const void*)fwd_megakernel, dim3(grid_blocks), dim3(512), args, LDS_TOTAL, stream);
    if (e != hipSuccess) fprintf(stderr, "cooperative launch failed: %s (grid %d)\n", hipGetErrorString(e), grid_blocks);
#endif
}
```

```cpp
#include <hip/hip_runtime.h>
#include <hip/hip_cooperative_groups.h>
#include <cstdio>
#include <cstring>
namespace cg = cooperative_groups;

#define LAS __attribute__((address_space(3)))
typedef unsigned short bf16_t;
typedef short bf16x8 __attribute__((ext_vector_type(8)));
typedef float f32x4 __attribute__((ext_vector_type(4)));
typedef float f32x2 __attribute__((ext_vector_type(2)));
typedef unsigned u32x4 __attribute__((ext_vector_type(4)));
typedef unsigned u32x2 __attribute__((ext_vector_type(2)));

constexpr int D = 1024, NB = 8, SEQ = 2048, DFF = 2816;
constexpr int MX = NB * SEQ;
constexpr int MMETA = NB * 16;
constexpr int MTOT = MX + MMETA;
constexpr int MP = 16640;
constexpr int LDS_BYTES = 131072;
constexpr int LDS_TOTAL = LDS_BYTES + 16;
constexpr float RMS_EPS = 1e-6f;
#define XCNT_WORDS (6 * 64 * 64 + 6 * 64)

typedef __bf16 bf16x2_t __attribute__((ext_vector_type(2)));
__device__ __forceinline__ unsigned cvt_pk_bf16(float lo, float hi) { const f32x2 v = {lo, hi}; const bf16x2_t b = __builtin_convertvector(v, bf16x2_t); return __builtin_bit_cast(unsigned, b); }
__device__ __forceinline__ void store_wt16(void* p, u32x4 v) { asm volatile("global_store_dwordx4 %0, %1, off sc1\n\ts_nop 1" :: "v"(p), "v"(v) : "memory"); }
__device__ __forceinline__ float bf2f(unsigned short b) { return __uint_as_float(((unsigned)b) << 16); }
__device__ __forceinline__ float bflo(unsigned w) { return __uint_as_float(w << 16); }
__device__ __forceinline__ float bfhi(unsigned w) { return __uint_as_float(w & 0xffff0000u); }

namespace pg8 {
constexpr int BM = 256, BK = 64, HALF = 128, HTB = HALF * BK * 2, STAGE_BYTES = 8 * HTB, NXCD = 8, WGM = 8;
__host__ __device__ __forceinline__ int lds_byte(int r, int c) { const int st = (r >> 4) * 2 + (c >> 5), rr = r & 15, cc = c & 31, ob = rr * 64 + cc * 2; return st * 1024 + (ob ^ (((ob >> 9) & 1) << 5)); }
__host__ __device__ __forceinline__ void stage_rc(int b, int& R, int& C) { const int st = b / 1024, sb = b % 1024, swz = sb ^ (((sb >> 9) & 1) << 5); R = (st >> 1) * 16 + swz / 64; C = (st & 1) * 32 + (swz % 64) / 2; }
__host__ __device__ __forceinline__ int perm32(int rho) { const int n = rho >> 4, i = rho & 15; return 8 * (i >> 2) + 4 * n + (i & 3); }

struct Unit { int pm, pn; };
struct Gemm { const bf16_t* A; const bf16_t* Bt; int M, N, K, lda; };
struct StaticOrder {
    int nM, nN, nwg, G, c, mode;
    __device__ void init(int M, int N, int G_, int c_, int mode_ = 0) { nM = M / BM; nN = N / BM; nwg = nM * nN; G = G_; c = c_; mode = mode_; }
    __device__ bool split_tail() const { const int rem = nwg % G; return rem > 0 && 2 * rem <= G; }
    __device__ bool next(int i, Unit& u) const {
        long L;
        if (mode == 2) { const int full = nwg / G, rem = nwg - full * G; if (i != 0 || c >= 2 * rem) return false; L = (long)full * G + (c >> 1); }
        else { L = (long)i * G + c; if (L >= nwg) return false; if (mode == 1 && i >= nwg / G) return false; }
        int wgid = (int)L; { const int q = nwg / NXCD, r = nwg % NXCD, xcd = wgid % NXCD, off = wgid / NXCD; wgid = (xcd < r ? xcd * (q + 1) : r * (q + 1) + (xcd - r) * q) + off; }
        const int nig = WGM * nN, gid = wgid / nig, fm = gid * WGM, gsz = (nM - fm) < WGM ? (nM - fm) : WGM;
        u.pm = fm + ((wgid % nig) % gsz); u.pn = (wgid % nig) / gsz; return true;
    }
};

template <class Epi, int HSEL = 0>
__device__ __forceinline__ void gemm_phase(LAS unsigned char* lds, const Gemm g, const StaticOrder& S, const Epi& E) {
    const int tid = threadIdx.x, wid = __builtin_amdgcn_readfirstlane(tid >> 6), lane = tid & 63, wr = wid >> 2, wc = wid & 3, fr = lane & 15, fq = lane >> 4;
    const int K = g.K, nt = K / BK;
    unsigned voffA[2], voffB[2];
#pragma unroll
    for (int i = 0; i < 2; ++i) { int R, C; stage_rc(tid * 16 + i * 8192, R, C); const int Rb = Epi::PERM ? ((R & ~31) + perm32(R & 31)) : R;
        voffA[i] = (unsigned)(R * g.lda + C) * 2u; voffB[i] = (unsigned)(Rb * K + C) * 2u; }
    const size_t kstep = (size_t)(BK * 2);
    const size_t hstep = (size_t)HALF * K * 2, hstepA = (size_t)HALF * g.lda * 2;
    const size_t tstep = 2 * hstep, tstepA = 2 * hstepA;
    const unsigned ldsw = (unsigned)wid * 1024u;
    const int aoff = lds_byte(wr * 64 + fr, fq * 8), boff = lds_byte(wc * 32 + fr, fq * 8);
#define PG8_SA(b, h) (((b) * 2 + (h)) * HTB)
#define PG8_SB(b, h) ((4 + (b) * 2 + (h)) * HTB)
#define PG8_STAGE(bufoff, gbase, voff) do { _Pragma("unroll") for (int _i = 0; _i < 2; ++_i) \
        __builtin_amdgcn_global_load_lds((const unsigned*)((const char*)(gbase) + (voff)[_i]), (LAS unsigned*)(lds + (bufoff) + ldsw + _i * 8192), 16, 0, 0); } while (0)
#define PG8_LDA(dst, b, h) do { _Pragma("unroll") for (int m = 0; m < 4; ++m) _Pragma("unroll") for (int k = 0; k < 2; ++k) dst[m][k] = *(const LAS bf16x8*)(lds + PG8_SA(b, h) + aoff + m * 2048 + k * 1024); } while (0)
#define PG8_LDB(dst, b, h) do { _Pragma("unroll") for (int n = 0; n < 2; ++n) _Pragma("unroll") for (int k = 0; k < 2; ++k) dst[n][k] = *(const LAS bf16x8*)(lds + PG8_SB(b, h) + boff + n * 2048 + k * 1024); } while (0)
#define PG8_MMA(ai, bj, At, Bt) do { __builtin_amdgcn_s_setprio(1); _Pragma("unroll") for (int m = 0; m < 4; ++m) _Pragma("unroll") for (int n = 0; n < 2; ++n) _Pragma("unroll") for (int k = 0; k < 2; ++k) \
        acc[ai][bj][m][n] = __builtin_amdgcn_mfma_f32_16x16x32_bf16(Bt[n][k], At[m][k], acc[ai][bj][m][n], 0, 0, 0); __builtin_amdgcn_s_setprio(0); } while (0)
#define PG8_KEEPA(X) do { _Pragma("unroll") for (int m = 0; m < 4; ++m) _Pragma("unroll") for (int k = 0; k < 2; ++k) asm volatile("" :: "v"(X[m][k])); } while (0)
#define PG8_WAIT_V(n) asm volatile("s_waitcnt vmcnt(" #n ")" ::: "memory")
#define PG8_WAIT_L(n) asm volatile("s_waitcnt lgkmcnt(" #n ")" ::: "memory")
#define PG8_BAR __builtin_amdgcn_s_barrier()
#define PG8_SCHED __builtin_amdgcn_sched_barrier(0)
    Unit cur, nxt; int ui = 0;
    if (!S.next(0, cur)) return;
    f32x4 acc[2][2][4][2];
#pragma unroll
    for (int a = 0; a < 2; ++a)
#pragma unroll
        for (int b = 0; b < 2; ++b)
#pragma unroll
            for (int m = 0; m < 4; ++m)
#pragma unroll
                for (int n = 0; n < 2; ++n) acc[a][b][m][n] = (f32x4){0.f, 0.f, 0.f, 0.f};
    bf16x8 At[4][2], B0[2][2], B1[2][2];
    const char* cA = (const char*)g.A + (size_t)cur.pm * tstepA; const char* cB = (const char*)g.Bt + (size_t)cur.pn * tstep;
    PG8_STAGE(PG8_SB(0, 0), cB, voffB); PG8_STAGE(PG8_SA(0, 0), cA, voffA); PG8_STAGE(PG8_SB(0, 1), cB + hstep, voffB); PG8_STAGE(PG8_SA(0, 1), cA + hstepA, voffA);
    if (wr == 1) PG8_BAR;
    PG8_WAIT_V(4); PG8_BAR;
    PG8_STAGE(PG8_SB(1, 0), cB + kstep, voffB); PG8_STAGE(PG8_SA(1, 0), cA + kstep, voffA); PG8_STAGE(PG8_SB(1, 1), cB + hstep + kstep, voffB);
    PG8_WAIT_V(6); PG8_BAR;
    for (;;) {
        const bool has_next = S.next(ui + 1, nxt);
        const char* nA = has_next ? (const char*)g.A + (size_t)nxt.pm * tstepA : cA; const char* nB = has_next ? (const char*)g.Bt + (size_t)nxt.pn * tstep : cB;
        for (int t = 0; t < nt; t += 2) {
            const bool last = (t == nt - 2);
            const char* a1 = cA + (size_t)(t + 1) * kstep;
            const char* a2 = last ? nA : cA + (size_t)(t + 2) * kstep; const char* b2 = last ? nB : cB + (size_t)(t + 2) * kstep;
            const char* a3 = a2 + kstep; const char* b3 = b2 + kstep;
            PG8_LDB(B0, 0, 0); PG8_SCHED; PG8_LDA(At, 0, 0); PG8_STAGE(PG8_SA(1, 1), a1 + hstepA, voffA);
            PG8_WAIT_L(8); PG8_BAR; PG8_WAIT_L(0); if (HSEL != 2) PG8_MMA(0, 0, At, B0); else PG8_KEEPA(At); PG8_BAR; PG8_SCHED;
            PG8_LDB(B1, 0, 1); PG8_STAGE(PG8_SB(0, 0), b2, voffB);
            PG8_BAR; PG8_WAIT_L(0); if (HSEL != 2) PG8_MMA(0, 1, At, B1); else PG8_KEEPA(At); PG8_BAR;
            PG8_LDA(At, 0, 1); PG8_STAGE(PG8_SA(0, 0), a2, voffA);
            PG8_BAR; PG8_WAIT_L(0); if (HSEL != 1) PG8_MMA(1, 0, At, B0); else PG8_KEEPA(At); PG8_BAR; PG8_SCHED;
            PG8_STAGE(PG8_SB(0, 1), b2 + hstep, voffB);
            PG8_WAIT_V(6); PG8_BAR; if (HSEL != 1) PG8_MMA(1, 1, At, B1); else PG8_KEEPA(At); PG8_BAR;
            PG8_LDB(B0, 1, 0); PG8_SCHED; PG8_LDA(At, 1, 0); PG8_STAGE(PG8_SA(0, 1), a2 + hstepA, voffA);
            PG8_WAIT_L(8); PG8_BAR; PG8_WAIT_L(0); if (HSEL != 2) PG8_MMA(0, 0, At, B0); else PG8_KEEPA(At); PG8_BAR; PG8_SCHED;
            PG8_LDB(B1, 1, 1); PG8_STAGE(PG8_SB(1, 0), b3, voffB);
            PG8_BAR; PG8_WAIT_L(0); if (HSEL != 2) PG8_MMA(0, 1, At, B1); else PG8_KEEPA(At); PG8_BAR;
            PG8_LDA(At, 1, 1); PG8_STAGE(PG8_SA(1, 0), a3, voffA);
            PG8_BAR; PG8_WAIT_L(0); if (HSEL != 1) PG8_MMA(1, 0, At, B0); else PG8_KEEPA(At); PG8_BAR; PG8_SCHED;
            PG8_STAGE(PG8_SB(1, 1), b3 + hstep, voffB);
            PG8_WAIT_V(6); PG8_BAR; if (HSEL != 1) PG8_MMA(1, 1, At, B1); else PG8_KEEPA(At); PG8_BAR;
        }
        if constexpr (!Epi::AFTER_DRAIN) E(acc, cur, wr, wc, fr, fq, HSEL);
        if (!has_next) break;
#pragma unroll
        for (int a = 0; a < 2; ++a)
#pragma unroll
            for (int b = 0; b < 2; ++b)
#pragma unroll
                for (int m = 0; m < 4; ++m)
#pragma unroll
                    for (int n = 0; n < 2; ++n) acc[a][b][m][n] = (f32x4){0.f, 0.f, 0.f, 0.f};
        cur = nxt; cA = nA; cB = nB; ++ui;
    }
    PG8_WAIT_V(0);
    if (wr == 0) PG8_BAR;
    PG8_BAR;
    if constexpr (Epi::AFTER_DRAIN) E.fused(acc, cur, wr, wc, fr, fq, lds, wid, lane);
#undef PG8_SA
#undef PG8_SB
#undef PG8_STAGE
#undef PG8_LDA
#undef PG8_LDB
#undef PG8_MMA
#undef PG8_KEEPA
#undef PG8_WAIT_V
#undef PG8_WAIT_L
#undef PG8_BAR
#undef PG8_SCHED
}
}
using pg8::Unit;

__device__ __forceinline__ float silu_f(float g) { return g * __builtin_amdgcn_rcpf(1.0f + __expf(-g)); }

struct EpiSwiGLU {
    static constexpr bool PERM = true, AFTER_DRAIN = false;
    bf16_t* O;
    __device__ __forceinline__ void operator()(const f32x4 (&acc)[2][2][4][2], const Unit& u, int wr, int wc, int fr, int fq, int half) const {
        const int row0 = u.pm * 256 + wr * 64 + fr, col0 = u.pn * 128 + wc * 32 + 8 * fq;
#pragma unroll
        for (int ai = 0; ai < 2; ++ai) {
            if (half == 2 - ai) continue;
#pragma unroll
            for (int m = 0; m < 4; ++m) {
                bf16_t* rowp = O + (size_t)(row0 + ai * 128 + m * 16) * DFF + col0;
                const f32x4 g0 = acc[ai][0][m][0], g1 = acc[ai][0][m][1], u0 = acc[ai][1][m][0], u1 = acc[ai][1][m][1];
                u32x4 w;
                w.x = cvt_pk_bf16(silu_f(g0[0]) * u0[0], silu_f(g0[1]) * u0[1]); w.y = cvt_pk_bf16(silu_f(g0[2]) * u0[2], silu_f(g0[3]) * u0[3]);
                w.z = cvt_pk_bf16(silu_f(g1[0]) * u1[0], silu_f(g1[1]) * u1[1]); w.w = cvt_pk_bf16(silu_f(g1[2]) * u1[2], silu_f(g1[3]) * u1[3]);
                store_wt16(rowp, w);
            }
        }
    }
};
struct EpiResid {
    static constexpr bool PERM = false, AFTER_DRAIN = false;
    const float* base_x; float* out_x; float scale;
    __device__ __forceinline__ void operator()(const f32x4 (&acc)[2][2][4][2], const Unit& u, int wr, int wc, int fr, int fq, int half) const {
        const int col0 = u.pn * 256 + wc * 32 + 4 * fq;
        const int row0 = u.pm * 256 + wr * 64 + fr;
#pragma unroll
        for (int ai = 0; ai < 2; ++ai) {
            if (half == 2 - ai) continue;
#pragma unroll
            for (int m = 0; m < 4; ++m) {
                const size_t off = (size_t)(row0 + ai * 128 + m * 16) * D + col0;
#pragma unroll
                for (int bj = 0; bj < 2; ++bj)
#pragma unroll
                    for (int n = 0; n < 2; ++n) {
                        const f32x4 b = *(const f32x4*)(base_x + off + bj * 128 + n * 16);
                        *(f32x4*)(out_x + off + bj * 128 + n * 16) = b + scale * acc[ai][bj][m][n];
                    }
            }
        }
    }
};
__device__ __forceinline__ bf16_t* hb_ptr(float* out, int r, int c) { return (bf16_t*)out + ((size_t)(r >> 8) * (256 * 1024 * 2) + (size_t)(r & 255) * 1024 + c); }
template <bool HALFS, bool FINAL, bool BASEF32> struct EpiResidNorm {
    static constexpr bool PERM = true, AFTER_DRAIN = true;
    const float* base_x; float* out_x; bf16_t* hn; const float* gain; float* xbuf; unsigned* cnt;
    __device__ __forceinline__ void fused(f32x4 (&acc)[2][2][4][2], const Unit& u, int wr, int wc, int fr, int fq, LAS unsigned char* lds, int wid, int lane) const {
        constexpr float scale = HALFS ? 0.5f : 1.0f;
        LAS float* P = (LAS float*)lds;
        LAS float* S = (LAS float*)(lds + 4096);
        const int col0 = u.pn * 256 + wc * 32 + 8 * fq, rt0 = wr * 64 + fr, tid = wid * 64 + lane;
#pragma unroll
        for (int ai = 0; ai < 2; ++ai)
#pragma unroll
            for (int m = 0; m < 4; ++m) {
                const int rt = rt0 + ai * 128 + m * 16, r = u.pm * 256 + rt;
                float ss = 0.f;
#pragma unroll
                for (int bj = 0; bj < 2; ++bj) {
                    f32x4 b0, b1;
                    if (BASEF32) { const float* bp = base_x + (size_t)r * D + col0 + bj * 128; b0 = __builtin_nontemporal_load((const f32x4*)bp); b1 = __builtin_nontemporal_load((const f32x4*)(bp + 4)); }
                    else { const u32x4 w = __builtin_nontemporal_load((const u32x4*)hb_ptr(out_x, r, col0 + bj * 128));     b0 = (f32x4){bflo(w.x), bfhi(w.x), bflo(w.y), bfhi(w.y)}; b1 = (f32x4){bflo(w.z), bfhi(w.z), bflo(w.w), bfhi(w.w)}; }
                    const f32x4 v0 = b0 + scale * acc[ai][bj][m][0], v1 = b1 + scale * acc[ai][bj][m][1];
                    acc[ai][bj][m][0] = v0; acc[ai][bj][m][1] = v1;
                    ss += (v0[0] * v0[0] + v0[1] * v0[1] + v0[2] * v0[2] + v0[3] * v0[3]) + (v1[0] * v1[0] + v1[1] * v1[1] + v1[2] * v1[2] + v1[3] * v1[3]);
                }
                ss += __shfl_xor(ss, 16); ss += __shfl_xor(ss, 32);
                if (fq == 0) P[rt * 4 + wc] = ss;
                if (BASEF32 || m == 3) asm volatile("" ::: "memory");
            }
        asm volatile("s_waitcnt lgkmcnt(0)" ::: "memory"); __builtin_amdgcn_s_barrier(); asm volatile("" ::: "memory");
        if (tid < 256) {
            const f32x4 q = *(const LAS f32x4*)(P + tid * 4);
            __hip_atomic_store(xbuf + ((size_t)u.pm * 256 + tid) * 4 + u.pn, (q[0] + q[1]) + (q[2] + q[3]), __ATOMIC_RELAXED, __HIP_MEMORY_SCOPE_AGENT);
        }
        asm volatile("s_waitcnt vmcnt(0)" ::: "memory");
        if (tid < 256 && lane == 0) __hip_atomic_fetch_add(cnt + 64 * u.pm, 1u, __ATOMIC_RELAXED, __HIP_MEMORY_SCOPE_AGENT);
        if (wid == 0) {
            unsigned sp = 0;
            while ((unsigned)__builtin_amdgcn_readfirstlane(__hip_atomic_load(cnt + 64 * u.pm, __ATOMIC_RELAXED, __HIP_MEMORY_SCOPE_AGENT)) < 16u) { __builtin_amdgcn_s_sleep(2); if (++sp > (1u << 20)) break; }
            __builtin_amdgcn_fence(__ATOMIC_ACQUIRE, "agent");
            asm volatile("s_waitcnt vmcnt(0)" ::: "memory");
        }
        asm volatile("s_waitcnt vmcnt(0) lgkmcnt(0)" ::: "memory"); __builtin_amdgcn_s_barrier(); asm volatile("" ::: "memory");
        if (tid < 256) {
            const float* slot = xbuf + ((size_t)u.pm * 256 + tid) * 4;
            const float a = __hip_atomic_load(slot + 0, __ATOMIC_RELAXED, __HIP_MEMORY_SCOPE_AGENT), b = __hip_atomic_load(slot + 1, __ATOMIC_RELAXED, __HIP_MEMORY_SCOPE_AGENT);
            const float c = __hip_atomic_load(slot + 2, __ATOMIC_RELAXED, __HIP_MEMORY_SCOPE_AGENT), d = __hip_atomic_load(slot + 3, __ATOMIC_RELAXED, __HIP_MEMORY_SCOPE_AGENT);
            S[tid] = rsqrtf(((a + b) + (c + d)) * (1.0f / D) + RMS_EPS);
        }
        asm volatile("s_waitcnt lgkmcnt(0)" ::: "memory"); __builtin_amdgcn_s_barrier(); asm volatile("" ::: "memory");
        f32x4 g[2][2];
#pragma unroll
        for (int bj = 0; bj < 2; ++bj)
#pragma unroll
            for (int n = 0; n < 2; ++n) g[bj][n] = *(const f32x4*)(gain + col0 + bj * 128 + n * 4);
#pragma unroll
        for (int ai = 0; ai < 2; ++ai)
#pragma unroll
            for (int m = 0; m < 4; ++m) {
                const int rt = rt0 + ai * 128 + m * 16;
                const size_t off = (size_t)(u.pm * 256 + rt) * D + col0;
                const float rs = S[rt];
#pragma unroll
                for (int bj = 0; bj < 2; ++bj) {
                    const f32x4 y0 = acc[ai][bj][m][0] * rs * g[bj][0], y1 = acc[ai][bj][m][1] * rs * g[bj][1];
                    if (FINAL) { __builtin_nontemporal_store(y0, (f32x4*)(out_x + off + bj * 128)); __builtin_nontemporal_store(y1, (f32x4*)(out_x + off + bj * 128 + 4)); }
                    else { u32x4 w; w.x = cvt_pk_bf16(y0[0], y0[1]); w.y = cvt_pk_bf16(y0[2], y0[3]); w.z = cvt_pk_bf16(y1[0], y1[1]); w.w = cvt_pk_bf16(y1[2], y1[3]); store_wt16(hn + off + bj * 128, w);
                           const f32x4 v0 = acc[ai][bj][m][0], v1 = acc[ai][bj][m][1];
                           u32x4 hw; hw.x = cvt_pk_bf16(v0[0], v0[1]); hw.y = cvt_pk_bf16(v0[2], v0[3]); hw.z = cvt_pk_bf16(v1[0], v1[1]); hw.w = cvt_pk_bf16(v1[2], v1[3]); store_wt16(hb_ptr(out_x, u.pm * 256 + rt, col0 + bj * 128), hw); }
                }
                asm volatile("" ::: "memory");
            }
    }
};
template <class Dst> struct EpiBf16T {
    static constexpr bool PERM = true, AFTER_DRAIN = false;
    Dst dst;
    __device__ __forceinline__ void operator()(const f32x4 (&acc)[2][2][4][2], const Unit& u, int wr, int wc, int fr, int fq, int half) const {
        const int row0 = u.pm * 256 + wr * 64 + fr, cw = wc * 32 + 8 * fq;
#pragma unroll
        for (int ai = 0; ai < 2; ++ai) {
            if (half == 2 - ai) continue;
#pragma unroll
            for (int m = 0; m < 4; ++m) {
                const int r = row0 + ai * 128 + m * 16;
#pragma unroll
                for (int bj = 0; bj < 2; ++bj) {
                    const f32x4 v0 = acc[ai][bj][m][0], v1 = acc[ai][bj][m][1];
                    u32x4 w; w.x = cvt_pk_bf16(v0[0], v0[1]); w.y = cvt_pk_bf16(v0[2], v0[3]); w.z = cvt_pk_bf16(v1[0], v1[1]); w.w = cvt_pk_bf16(v1[2], v1[3]);
                    store_wt16(dst(r, u.pn, bj, cw), w);
                }
            }
        }
    }
};
constexpr int NTOK = 16 + SEQ;
struct DstDaQK { bf16_t* Qd; bf16_t* Kh;
    __device__ __forceinline__ bf16_t* operator()(int r, int pn, int bj, int cw) const {
        if (pn < 4) return Qd + (size_t)r * 1024 + pn * 256 + bj * 128 + cw;
        const int b = r >> 11, s = r & 2047, h = 2 * (pn - 4) + bj;
        return Kh + ((size_t)(b * 8 + h) * NTOK + 16 + s) * 128 + cw; } };
struct DstGlaMain { bf16_t* qh; bf16_t* g2;
    __device__ __forceinline__ bf16_t* operator()(int r, int pn, int bj, int cw) const {
        if (pn >= 2) return g2 + (size_t)r * 1536 + (pn - 2) * 256 + bj * 128 + cw;
        const int b = r >> 11, s = r & 2047, h = 2 * pn + bj;
        return qh + ((size_t)(b * 4 + h) * NTOK + 16 + s) * 128 + cw; } };
struct DstVTc { bf16_t* vtc;
    __device__ __forceinline__ bf16_t* operator()(int f, int pn, int bj, int cw) const {
        const int tok = pn * 256 + bj * 128 + cw, b = tok >> 11, s = tok & 2047;
        return vtc + ((size_t)(b * 33 + 1 + (s >> 6)) * 1024 + f) * 64 + (s & 63); } };
struct Job { const float* src; bf16_t* dst; int ldw, K, ndst, col0, mode, nvalid, tile0, pad; };
struct Params {
    const float *x, *meta, *ffn1_norm, *mix_norm, *ffn2_norm, *da_lambda, *da_subln, *gla_w_gate2, *gla_b_gate2, *gla_norm, *final_norm;
    float* out;
    bf16_t* w_ffn_in[4]; bf16_t* w_ffn_out[4];
    bf16_t *w_da_qk, *w_da_v, *w_da_out, *w_gla_main, *w_gla_v, *w_gla_out;
    bf16_t *big, *hn, *kdecT;
    bf16_t *qd, *kh, *vtc_da, *g2, *qh, *vtc_gla;
    float *hmeta, *glr, *decay;
    unsigned* bar; unsigned* xcnt; float* xbuf;
    Job jobs[16];
    int njobs, ntiles_prep, ph_lo, ph_hi;
};

__device__ __forceinline__ void prep_phase(const Params& p, unsigned char* shm) {
    float* tile = (float*)shm;
    const int tid = threadIdx.x;
    const int n4 = (tid & 31) * 4, kk0 = tid >> 5;
#define PREP_FETCH(T, V, DST, KK, K0, N0, VALID) do { \
        int j_ = 0; for (int q = 1; q < p.njobs; ++q) if ((T) >= p.jobs[q].tile0) j_ = q; \
        const Job jb = p.jobs[j_]; \
        const int lt = (T) - jb.tile0, nkt = jb.K / 128, kt = lt % nkt, ntile = lt / nkt; \
        K0 = kt * 128; N0 = ntile * 128; KK = jb.K; DST = jb.dst; \
        int scol; if (jb.mode == 1) { const int pn = N0 >> 8, bj = (N0 >> 7) & 1; scol = bj * DFF + 128 * pn; } else scol = jb.col0 + N0; \
        VALID = N0 < jb.nvalid; \
        if (VALID) { \
            _Pragma("unroll") for (int i = 0; i < 8; ++i) { \
                const float* s = jb.src + (size_t)(K0 + kk0 + 16 * i) * jb.ldw + scol + n4; \
                if (N0 + n4 + 3 < jb.nvalid) V[i] = __builtin_nontemporal_load((const f32x4*)s);     \
                else { for (int q = 0; q < 4; ++q) V[i][q] = (N0 + n4 + q < jb.nvalid) ? s[q] : 0.f; } } } } while (0)
    f32x4 v[8], vn[8];
    bf16_t* dstc = nullptr; bf16_t* dstn = nullptr; int Kc = 0, k0c = 0, n0c = 0, Kn = 0, k0n = 0, n0n = 0; bool validc = false, validn = false;
    int t = blockIdx.x;
    if (t < p.ntiles_prep) PREP_FETCH(t, v, dstc, Kc, k0c, n0c, validc);
    for (; t < p.ntiles_prep; t += gridDim.x) {
        const int tn = t + gridDim.x;
        if (tn < p.ntiles_prep) PREP_FETCH(tn, vn, dstn, Kn, k0n, n0n, validn);
        __syncthreads();
        if (validc) {
#pragma unroll
            for (int i = 0; i < 8; ++i) { float* tp = tile + (kk0 + 16 * i) * 129 + n4; tp[0] = v[i][0]; tp[1] = v[i][1]; tp[2] = v[i][2]; tp[3] = v[i][3]; }
        }
        __syncthreads();
        const int nn = (tid & 31) + 32 * ((tid >> 6) & 3), ks = ((tid >> 5) & 1) + 2 * (tid >> 8);
        bf16_t* dp = dstc + (size_t)(n0c + nn) * Kc + k0c + ks * 32;
#pragma unroll
        for (int q4 = 0; q4 < 4; ++q4) {
            u32x4 w = (u32x4){0u, 0u, 0u, 0u};
            if (validc) {
                float x[8];
#pragma unroll
                for (int q = 0; q < 8; ++q) x[q] = tile[(ks * 32 + q4 * 8 + q) * 129 + nn];
                w.x = cvt_pk_bf16(x[0], x[1]); w.y = cvt_pk_bf16(x[2], x[3]); w.z = cvt_pk_bf16(x[4], x[5]); w.w = cvt_pk_bf16(x[6], x[7]);
            }
            *(u32x4*)(dp + q4 * 8) = w;
        }
#pragma unroll
        for (int i = 0; i < 8; ++i) v[i] = vn[i];
        dstc = dstn; Kc = Kn; k0c = k0n; n0c = n0n; validc = validn;
    }
#undef PREP_FETCH
    for (int i = blockIdx.x * 512 + tid; i < XCNT_WORDS; i += gridDim.x * 512) p.xcnt[i] = 0u;
    for (int i = blockIdx.x * 512 + tid; i < MMETA * D / 4; i += gridDim.x * 512) {
        const int row = i / (D / 4), c4 = i % (D / 4);
        ((f32x4*)p.hmeta)[i] = ((const f32x4*)p.meta)[(row & 15) * (D / 4) + c4];
    }
}

__device__ __forceinline__ void norm_phase(const Params& p, const float* srcx, const float* gain, bool final_out, bool first = false) {
    const int wid = threadIdx.x >> 6, lane = threadIdx.x & 63;
    const int nrows = final_out ? MX : MTOT, stride = gridDim.x * 8;
    f32x4 g[4];
#pragma unroll
    for (int i = 0; i < 4; ++i) g[i] = *(const f32x4*)(gain + i * 256 + lane * 4);
    auto rowsrc = [&](int row) { return row < MX ? srcx + (size_t)row * D : (first ? p.meta + (size_t)((row - MX) & 15) * D : p.hmeta + (size_t)(row - MX) * D); };
    int row = blockIdx.x * 8 + wid;
    f32x4 v[4], vn[4];
    if (row < nrows) { const float* src = rowsrc(row);
#pragma unroll
        for (int i = 0; i < 4; ++i) v[i] = first ? __builtin_nontemporal_load((const f32x4*)(src + i * 256 + lane * 4)) : *(const f32x4*)(src + i * 256 + lane * 4); }
    for (; row < nrows; row += stride) {
        const int nrow = row + stride;
        if (nrow < nrows) { const float* src = rowsrc(nrow);
#pragma unroll
            for (int i = 0; i < 4; ++i) vn[i] = first ? __builtin_nontemporal_load((const f32x4*)(src + i * 256 + lane * 4)) : *(const f32x4*)(src + i * 256 + lane * 4); }
        float ss = 0.f;
#pragma unroll
        for (int i = 0; i < 4; ++i) ss += v[i][0] * v[i][0] + v[i][1] * v[i][1] + v[i][2] * v[i][2] + v[i][3] * v[i][3];
#pragma unroll
        for (int o = 32; o >= 1; o >>= 1) ss += __shfl_xor(ss, o);
        const float rstd = rsqrtf(ss * (1.0f / D) + RMS_EPS);
        if (final_out) {
            float* dst = p.out + (size_t)row * D;
#pragma unroll
            for (int i = 0; i < 4; ++i) *(f32x4*)(dst + i * 256 + lane * 4) = v[i] * rstd * g[i];
        } else {
            bf16_t* dst = p.hn + (size_t)row * D;
#pragma unroll
            for (int i = 0; i < 4; ++i) { const f32x4 y = v[i] * rstd * g[i]; u32x2 w; w.x = cvt_pk_bf16(y[0], y[1]); w.y = cvt_pk_bf16(y[2], y[3]); *(u32x2*)(dst + i * 256 + lane * 4) = w; }
        }
#pragma unroll
        for (int i = 0; i < 4; ++i) v[i] = vn[i];
    }
}

__device__ __forceinline__ void attn_phase(const Params& p, unsigned char* shm) {
    const int tid = threadIdx.x, wid = tid >> 6, lane = tid & 63, fr = lane & 15, fq = lane >> 4;
    const int qi = wid & 3, mp = wid >> 2;
    bf16_t* Ksb = (bf16_t*)shm;
    bf16_t* Vsb = (bf16_t*)(shm + 2 * 17408);
    float* Xs = (float*)shm;
    float lam;
    { float s0 = 0.f, s1 = 0.f; for (int d = 0; d < 64; ++d) { s0 += p.da_lambda[d] * p.da_lambda[64 + d]; s1 += p.da_lambda[128 + d] * p.da_lambda[192 + d]; }
      lam = __expf(s0) - __expf(s1) + 0.2f; }
    const float lam_init = 0.2f;
    const float sc2 = 0.125f * 1.44269504089f;
    const int kr0 = tid >> 4, kc0 = (tid & 15) * 8, vr0 = tid >> 3, vc0 = (tid & 7) * 8;
    const int kp0 = 16 * ((kr0 >> 2) & 1) + 4 * (kr0 >> 3) + (kr0 & 3);
    for (int v = blockIdx.x; v < 256; v += gridDim.x) {
        const int xcd = v & 7, slot = v >> 3, bh = xcd * 8 + (slot >> 2), jj = slot & 3, b = bh >> 3, h = bh & 7;
        const int nitems = (jj == 0) ? 5 : 4;
        const bf16_t* kbase = p.kh + ((size_t)(b * 8 + h) * NTOK + kr0) * 128 + kc0;
        const bf16_t* vbase = p.vtc_da + ((size_t)(b * 33) * 1024 + h * 128 + vr0) * 64 + vc0;
        for (int it = 0; it < nitems; ++it) {
            const bool meta = (it == 4);
            const int pp = meta ? 0 : ((it & 1) ? (8 * (it >> 1) + 7 - jj) : (8 * (it >> 1) + jj));
            const int ntiles = meta ? 1 : 2 * pp + 3;
            const int qrowA = (meta ? MX + b * 16 : b * SEQ + 128 * pp) + 16 * qi + fr;
            const int qrowB = meta ? qrowA : qrowA + 64;
            u32x4 kreg[2], vreg[2];
            { kreg[0] = *(const u32x4*)(kbase); kreg[1] = *(const u32x4*)(kbase + 32 * 128);
              vreg[0] = *(const u32x4*)(vbase); vreg[1] = *(const u32x4*)(vbase + 64 * 64); }
            bf16x8 Qf[2][2];
#pragma unroll
            for (int kd = 0; kd < 2; ++kd) { Qf[0][kd] = *(const bf16x8*)(p.qd + (size_t)qrowA * 1024 + h * 128 + mp * 64 + kd * 32 + fq * 8);
                                             Qf[1][kd] = *(const bf16x8*)(p.qd + (size_t)qrowB * 1024 + h * 128 + mp * 64 + kd * 32 + fq * 8); }
            f32x4 accO[2][8];
#pragma unroll
            for (int blk = 0; blk < 2; ++blk)
#pragma unroll
                for (int nb = 0; nb < 8; ++nb) accO[blk][nb] = (f32x4){0.f, 0.f, 0.f, 0.f};
            float mrun[2] = {-INFINITY, -INFINITY}, lrun[2] = {0.f, 0.f};
            __syncthreads();
            *(u32x4*)(Ksb + kp0 * 136 + kc0) = kreg[0]; *(u32x4*)(Ksb + (kp0 + 32) * 136 + kc0) = kreg[1];
            *(u32x4*)(Vsb + vr0 * 72 + vc0) = vreg[0]; *(u32x4*)(Vsb + (vr0 + 64) * 72 + vc0) = vreg[1];
            __syncthreads();
            for (int t = 0; t < ntiles; ++t) {
                const bf16_t* Ks = Ksb + (t & 1) * (64 * 136);
                const bf16_t* Vs = Vsb + (t & 1) * (128 * 72);
                if (t + 1 < ntiles) {
                    const bf16_t* kp = kbase + (size_t)(16 + 64 * t) * 128; const bf16_t* vp = vbase + (size_t)(t + 1) * 65536;
                    kreg[0] = *(const u32x4*)(kp); kreg[1] = *(const u32x4*)(kp + 32 * 128);
                    vreg[0] = *(const u32x4*)(vp); vreg[1] = *(const u32x4*)(vp + 64 * 64);
                }
                const bool actA = meta || (t + 1 < ntiles);
                f32x4 s[2][2][2];
                __builtin_amdgcn_s_setprio(1);
#pragma unroll
                for (int ks = 0; ks < 2; ++ks)
#pragma unroll
                    for (int a = 0; a < 2; ++a) {
                        f32x4 zA = (f32x4){0.f, 0.f, 0.f, 0.f}, zB = (f32x4){0.f, 0.f, 0.f, 0.f};
#pragma unroll
                        for (int kd = 0; kd < 2; ++kd) { const bf16x8 kf = *(const bf16x8*)(Ks + (32 * ks + 16 * a + fr) * 136 + mp * 64 + kd * 32 + fq * 8);
                            zA = __builtin_amdgcn_mfma_f32_16x16x32_bf16(kf, Qf[0][kd], zA, 0, 0, 0); zB = __builtin_amdgcn_mfma_f32_16x16x32_bf16(kf, Qf[1][kd], zB, 0, 0, 0); }
                        s[0][ks][a] = zA; s[1][ks][a] = zB;
                    }
                __builtin_amdgcn_s_setprio(0);
                if (t == 0) {
#pragma unroll
                    for (int blk = 0; blk < 2; ++blk)
#pragma unroll
                        for (int ks = 0; ks < 2; ++ks)
#pragma unroll
                            for (int a = 0; a < 2; ++a)
#pragma unroll
                                for (int j = 0; j < 4; ++j) if (32 * ks + 8 * fq + 4 * a + j >= 16) s[blk][ks][a][j] = -INFINITY;
                }
                bf16x8 Pf[2][2]; float alpha[2];
#pragma unroll
                for (int blk = 0; blk < 2; ++blk) {
                    float tm = -INFINITY;
#pragma unroll
                    for (int ks = 0; ks < 2; ++ks)
#pragma unroll
                        for (int a = 0; a < 2; ++a)
#pragma unroll
                            for (int j = 0; j < 4; ++j) tm = fmaxf(tm, s[blk][ks][a][j]);
                    tm = fmaxf(tm, __shfl_xor(tm, 16)); tm = fmaxf(tm, __shfl_xor(tm, 32));
                    const float mnew = fmaxf(mrun[blk], tm * sc2);
                    alpha[blk] = __builtin_amdgcn_exp2f(mrun[blk] - mnew);
                    float ps = 0.f;
#pragma unroll
                    for (int ks = 0; ks < 2; ++ks) {
                        float e[8];
#pragma unroll
                        for (int a = 0; a < 2; ++a)
#pragma unroll
                            for (int j = 0; j < 4; ++j) { e[4 * a + j] = __builtin_amdgcn_exp2f(__builtin_fmaf(s[blk][ks][a][j], sc2, -mnew)); ps += e[4 * a + j]; }
                        u32x4 w; w.x = cvt_pk_bf16(e[0], e[1]); w.y = cvt_pk_bf16(e[2], e[3]); w.z = cvt_pk_bf16(e[4], e[5]); w.w = cvt_pk_bf16(e[6], e[7]);
                        Pf[blk][ks] = __builtin_bit_cast(bf16x8, w);
                    }
                    if (blk == 1 || actA) { mrun[blk] = mnew; lrun[blk] = lrun[blk] * alpha[blk] + ps; }
                }
                __builtin_amdgcn_s_setprio(1);
                if (actA) {
#pragma unroll
                    for (int nb = 0; nb < 8; ++nb) {
                        f32x4 oA = accO[0][nb] * alpha[0], oB = accO[1][nb] * alpha[1];
#pragma unroll
                        for (int ks = 0; ks < 2; ++ks) { const bf16x8 vf = *(const bf16x8*)(Vs + (nb * 16 + fr) * 72 + ks * 32 + fq * 8);
                            oA = __builtin_amdgcn_mfma_f32_16x16x32_bf16(vf, Pf[0][ks], oA, 0, 0, 0); oB = __builtin_amdgcn_mfma_f32_16x16x32_bf16(vf, Pf[1][ks], oB, 0, 0, 0); }
                        accO[0][nb] = oA; accO[1][nb] = oB;
                    }
                } else {
#pragma unroll
                    for (int nb = 0; nb < 8; ++nb) {
                        f32x4 oB = accO[1][nb] * alpha[1];
#pragma unroll
                        for (int ks = 0; ks < 2; ++ks) { const bf16x8 vf = *(const bf16x8*)(Vs + (nb * 16 + fr) * 72 + ks * 32 + fq * 8); oB = __builtin_amdgcn_mfma_f32_16x16x32_bf16(vf, Pf[1][ks], oB, 0, 0, 0); }
                        accO[1][nb] = oB;
                    }
                }
                __builtin_amdgcn_s_setprio(0);
                if (t + 1 < ntiles) {
                    bf16_t* Kn = Ksb + ((t + 1) & 1) * (64 * 136); bf16_t* Vn = Vsb + ((t + 1) & 1) * (128 * 72);
                    *(u32x4*)(Kn + kp0 * 136 + kc0) = kreg[0]; *(u32x4*)(Kn + (kp0 + 32) * 136 + kc0) = kreg[1];
                    *(u32x4*)(Vn + vr0 * 72 + vc0) = vreg[0]; *(u32x4*)(Vn + (vr0 + 64) * 72 + vc0) = vreg[1];
                }
                __syncthreads();
            }
            float inv[2];
#pragma unroll
            for (int blk = 0; blk < 2; ++blk) { float l = lrun[blk]; l += __shfl_xor(l, 16); l += __shfl_xor(l, 32); inv[blk] = 1.0f / l; }
            if (mp == 1) {
#pragma unroll
                for (int blk = 0; blk < 2; ++blk)
#pragma unroll
                    for (int nb = 0; nb < 8; ++nb) *(f32x4*)(Xs + ((blk * 4 + qi) * 16 + fr) * 132 + nb * 16 + fq * 4) = accO[blk][nb] * inv[blk];
            }
            __syncthreads();
            if (mp == 0) {
#pragma unroll
                for (int blk = 0; blk < 2; ++blk) {
                    if (meta && (blk == 1 || qi != 0)) continue;
                    float ss = 0.f;
#pragma unroll
                    for (int nb = 0; nb < 8; ++nb) { const f32x4 o2 = *(const f32x4*)(Xs + ((blk * 4 + qi) * 16 + fr) * 132 + nb * 16 + fq * 4); const f32x4 o = accO[blk][nb] * inv[blk] - lam * o2; accO[blk][nb] = o; ss += o[0] * o[0] + o[1] * o[1] + o[2] * o[2] + o[3] * o[3]; }
                    ss += __shfl_xor(ss, 16); ss += __shfl_xor(ss, 32);
                    const float rs = rsqrtf(ss * (1.0f / 128.0f) + RMS_EPS) * (1.0f - lam_init);
                    bf16_t* dst = p.qd + (size_t)(blk ? qrowB : qrowA) * D + h * 128 + fq * 4;
#pragma unroll
                    for (int nb = 0; nb < 8; ++nb) { const f32x4 gg = *(const f32x4*)(p.da_subln + nb * 16 + fq * 4); const f32x4 y = accO[blk][nb] * rs * gg;
                        u32x2 w; w.x = cvt_pk_bf16(y[0], y[1]); w.y = cvt_pk_bf16(y[2], y[3]); *(u32x2*)(dst + nb * 16) = w; }
                }
            }
        }
    }
}

__device__ __forceinline__ void gla_prep_phase(const Params& p, unsigned char* shm) {
    float* gl = (float*)shm;
    bf16_t* kt = (bf16_t*)(shm + 4096);
    const int tid = threadIdx.x;
    float w2[16];
#pragma unroll
    for (int r = 0; r < 16; ++r) w2[r] = p.gla_w_gate2[r * 512 + tid];
    const float bias = p.gla_b_gate2[tid];
    for (int it = blockIdx.x; it < NB * 33; it += gridDim.x) {
        const int b = it < 256 ? (it >> 5) : (it - 256), ch = it < 256 ? 1 + (it & 31) : 0;
        const int item = b * 33 + ch;
        const int row0 = ch == 0 ? MX + b * 16 : b * SEQ + 64 * (ch - 1);
        const int nvalid = ch == 0 ? 16 : 64;
        __syncthreads();
        for (int i = tid; i < 1024; i += 512) gl[i] = p.glr[(size_t)row0 * 16 + i];
        { u32x4 kv[8];
#pragma unroll
          for (int i = 0; i < 8; ++i) { const int ch16 = tid + 512 * i, r = ch16 >> 6, c8 = (ch16 & 63) * 8; const int rr = r < nvalid ? r : nvalid - 1;
              kv[i] = *(const u32x4*)(p.g2 + (size_t)(row0 + rr) * 1536 + c8); }
#pragma unroll
          for (int i = 0; i < 8; ++i) { const int ch16 = tid + 512 * i, r = ch16 >> 6, c8 = (ch16 & 63) * 8; *(u32x4*)(kt + r * 512 + c8) = kv[i]; } }
        __syncthreads();
        float gend = 0.f;
        for (int t = 0; t < nvalid; ++t) {
            float z = bias;
#pragma unroll
            for (int r = 0; r < 16; ++r) z += gl[t * 16 + r] * w2[r];
            gend += (fminf(z, 0.f) - __logf(1.0f + __expf(-fabsf(z)))) * (1.0f / 16.0f);
        }
        p.decay[(size_t)item * 512 + tid] = __expf(gend);
        bf16_t* dst = p.kdecT + ((size_t)item * 512 + tid) * 64;
        float G = 0.f;
        for (int t8 = 0; t8 < 8; ++t8) {
            float kd[8];
#pragma unroll
            for (int q = 0; q < 8; ++q) {
                const int t = t8 * 8 + q;
                float val = 0.f;
                if (t < nvalid) {
                    float z = bias;
#pragma unroll
                    for (int r = 0; r < 16; ++r) z += gl[t * 16 + r] * w2[r];
                    G += (fminf(z, 0.f) - __logf(1.0f + __expf(-fabsf(z)))) * (1.0f / 16.0f);
                    val = bf2f(kt[t * 512 + tid]) * __expf(gend - G);
                }
                kd[q] = val;
            }
            u32x4 w; w.x = cvt_pk_bf16(kd[0], kd[1]); w.y = cvt_pk_bf16(kd[2], kd[3]); w.z = cvt_pk_bf16(kd[4], kd[5]); w.w = cvt_pk_bf16(kd[6], kd[7]);
            *(u32x4*)(dst + t8 * 8) = w;
        }
    }
}

struct ScanOps { bf16x8 Af[2], Bf[2][2], Qf[4]; f32x4 dc; };
__device__ __forceinline__ void scan_load(ScanOps& o, const Params& p, int b, int h, int dvs, int ch, int wid, int fr, int fq) {
    const int item = b * 33 + ch;
    const int tok0 = ch == 0 ? 0 : 16 + 64 * (ch - 1);
    const int tb = wid >> 1;
#pragma unroll
    for (int ks = 0; ks < 2; ++ks) {
        o.Af[ks] = *(const bf16x8*)(p.kdecT + ((size_t)item * 512 + h * 128 + wid * 16 + fr) * 64 + ks * 32 + fq * 8);
#pragma unroll
        for (int vb = 0; vb < 2; ++vb) o.Bf[vb][ks] = *(const bf16x8*)(p.vtc_gla + ((size_t)item * 1024 + h * 256 + dvs * 32 + vb * 16 + fr) * 64 + ks * 32 + fq * 8);
    }
    o.dc = *(const f32x4*)(p.decay + (size_t)item * 512 + h * 128 + wid * 16 + fq * 4);
#pragma unroll
    for (int kc = 0; kc < 4; ++kc) o.Qf[kc] = *(const bf16x8*)(p.qh + ((size_t)(b * 4 + h) * NTOK + tok0 + tb * 16 + fr) * 128 + kc * 32 + fq * 8);
}
__device__ __forceinline__ void gla_scan_phase(const Params& p, unsigned char* shm) {
    const int tid = threadIdx.x, wid = tid >> 6, lane = tid & 63, fr = lane & 15, fq = lane >> 4;
    bf16_t* Ssb = (bf16_t*)shm;
    const float qscale = 0.08838834764831845f;
    for (int wg = blockIdx.x; wg < 256; wg += gridDim.x) {
        const int xcd_ = wg & 7, slot_ = wg >> 3, bh_ = xcd_ * 4 + (slot_ >> 3);
        const int b = bh_ >> 2, h = bh_ & 3, dvs = slot_ & 7;
        f32x4 accS[2] = {(f32x4){0.f, 0.f, 0.f, 0.f}, (f32x4){0.f, 0.f, 0.f, 0.f}};
        const int tb = wid >> 1, vb2 = wid & 1;
        ScanOps r0, r1, r2, r3;
        scan_load(r0, p, b, h, dvs, 0, wid, fr, fq);
        scan_load(r1, p, b, h, dvs, 1, wid, fr, fq);
        scan_load(r2, p, b, h, dvs, 2, wid, fr, fq);
        __syncthreads();
#define SCAN_STEP(CUR, NXT, CH) do { const int ch_ = (CH); \
            const int row0 = ch_ == 0 ? MX + b * 16 : b * SEQ + 64 * (ch_ - 1); const int nvalid = ch_ == 0 ? 16 : 64; \
            bf16_t* Ss = Ssb + (ch_ & 1) * (32 * 136); \
            if (ch_ + 3 < 33) scan_load(NXT, p, b, h, dvs, ch_ + 3, wid, fr, fq); \
            _Pragma("unroll") for (int vb = 0; vb < 2; ++vb) { \
                f32x4 s = accS[vb] * CUR.dc; \
                _Pragma("unroll") for (int ks = 0; ks < 2; ++ks) s = __builtin_amdgcn_mfma_f32_16x16x32_bf16(CUR.Af[ks], CUR.Bf[vb][ks], s, 0, 0, 0); \
                accS[vb] = s; \
                u32x2 w; w.x = cvt_pk_bf16(s[0], s[1]); w.y = cvt_pk_bf16(s[2], s[3]); \
                *(u32x2*)(Ss + (vb * 16 + fr) * 136 + wid * 16 + fq * 4) = w; } \
            asm volatile("s_waitcnt lgkmcnt(0)" ::: "memory"); __builtin_amdgcn_s_barrier(); asm volatile("" ::: "memory");     \
            f32x4 o = (f32x4){0.f, 0.f, 0.f, 0.f}; \
            _Pragma("unroll") for (int kc = 0; kc < 4; ++kc) { const bf16x8 sf = *(const bf16x8*)(Ss + (vb2 * 16 + fr) * 136 + kc * 32 + fq * 8); o = __builtin_amdgcn_mfma_f32_16x16x32_bf16(sf, CUR.Qf[kc], o, 0, 0, 0); } \
            if (tb * 16 + fr < nvalid) { o = o * qscale; u32x2 w; w.x = cvt_pk_bf16(o[0], o[1]); w.y = cvt_pk_bf16(o[2], o[3]); \
                *(u32x2*)(p.hn + (size_t)(row0 + tb * 16 + fr) * D + h * 256 + dvs * 32 + vb2 * 16 + fq * 4) = w; } \
        } while (0)
        for (int c4 = 0; c4 < 32; c4 += 4) {
            SCAN_STEP(r0, r3, c4); SCAN_STEP(r1, r0, c4 + 1); SCAN_STEP(r2, r1, c4 + 2); SCAN_STEP(r3, r2, c4 + 3);
        }
        SCAN_STEP(r0, r3, 32);
#undef SCAN_STEP
        __syncthreads();
    }
}

__device__ __forceinline__ void gla_post_phase(const Params& p) {
    const int wid = threadIdx.x >> 6, lane = threadIdx.x & 63, stride = gridDim.x * 8;
    const f32x4 g = *(const f32x4*)(p.gla_norm + lane * 4);
    int row = blockIdx.x * 8 + wid;
    u32x2 ow[4], gw[4], own[4], gwn[4];
    if (row < MTOT) {
#pragma unroll
        for (int h = 0; h < 4; ++h) { ow[h] = *(const u32x2*)(p.hn + (size_t)row * D + h * 256 + lane * 4); gw[h] = *(const u32x2*)(p.g2 + (size_t)row * 1536 + 512 + h * 256 + lane * 4); } }
    for (; row < MTOT; row += stride) {
        const int nrow = row + stride;
        if (nrow < MTOT) {
#pragma unroll
            for (int h = 0; h < 4; ++h) { own[h] = *(const u32x2*)(p.hn + (size_t)nrow * D + h * 256 + lane * 4); gwn[h] = *(const u32x2*)(p.g2 + (size_t)nrow * 1536 + 512 + h * 256 + lane * 4); } }
#pragma unroll
        for (int h = 0; h < 4; ++h) {
            const float o0 = bflo(ow[h].x), o1 = bfhi(ow[h].x), o2 = bflo(ow[h].y), o3 = bfhi(ow[h].y);
            float ss = o0 * o0 + o1 * o1 + o2 * o2 + o3 * o3;
#pragma unroll
            for (int o = 32; o >= 1; o >>= 1) ss += __shfl_xor(ss, o);
            const float rs = rsqrtf(ss * (1.0f / 256.0f) + RMS_EPS);
            const float y0 = o0 * rs * g[0] * silu_f(bflo(gw[h].x)), y1 = o1 * rs * g[1] * silu_f(bfhi(gw[h].x)), y2 = o2 * rs * g[2] * silu_f(bflo(gw[h].y)), y3 = o3 * rs * g[3] * silu_f(bfhi(gw[h].y));
            u32x2 w; w.x = cvt_pk_bf16(y0, y1); w.y = cvt_pk_bf16(y2, y3);
            *(u32x2*)(p.g2 + (size_t)row * 1536 + 512 + h * 256 + lane * 4) = w;
        }
#pragma unroll
        for (int h = 0; h < 4; ++h) { ow[h] = own[h]; gw[h] = gwn[h]; }
    }
}

template <int NBLK, bool TRANS_OUT, class Fin>
__device__ __forceinline__ void small_gemm_item(unsigned char* shm, const bf16_t* A, int lda, const bf16_t* Bt0, const bf16_t* Bt1, int K, const Fin& fin) {
    const int tid = threadIdx.x, wid = tid >> 6, lane = tid & 63, fr = lane & 15, fq = lane >> 4;
    const int kw = K >> 3, k0 = wid * kw;
    f32x4 acc[8][NBLK];
#pragma unroll
    for (int rb = 0; rb < 8; ++rb)
#pragma unroll
        for (int cb = 0; cb < NBLK; ++cb) acc[rb][cb] = (f32x4){0.f, 0.f, 0.f, 0.f};
    const bf16_t* ap = A + (size_t)fr * lda + k0 + fq * 8;
    const bf16_t* bp0 = Bt0 + (size_t)fr * K + k0 + fq * 8;
    const bf16_t* bp1 = Bt1 + (size_t)fr * K + k0 + fq * 8;
    bf16x8 bf[NBLK], af[8], bfn[NBLK], afn[8];
    bf[0] = *(const bf16x8*)(bp0);
    if (NBLK > 1) bf[NBLK - 1] = *(const bf16x8*)(bp1);
#pragma unroll
    for (int rb = 0; rb < 8; ++rb) af[rb] = *(const bf16x8*)(ap + (size_t)rb * 16 * lda);
#pragma unroll 1
    for (int k = 0; k < kw; k += 32) {
        const int kn = (k + 32 < kw) ? k + 32 : k;
        bfn[0] = *(const bf16x8*)(bp0 + kn);
        if (NBLK > 1) bfn[NBLK - 1] = *(const bf16x8*)(bp1 + kn);
#pragma unroll
        for (int rb = 0; rb < 8; ++rb) afn[rb] = *(const bf16x8*)(ap + (size_t)rb * 16 * lda + kn);
#pragma unroll
        for (int rb = 0; rb < 8; ++rb)
#pragma unroll
            for (int cb = 0; cb < NBLK; ++cb)
                acc[rb][cb] = TRANS_OUT ? __builtin_amdgcn_mfma_f32_16x16x32_bf16(af[rb], bf[cb], acc[rb][cb], 0, 0, 0)
                                        : __builtin_amdgcn_mfma_f32_16x16x32_bf16(bf[cb], af[rb], acc[rb][cb], 0, 0, 0);
#pragma unroll
        for (int cb = 0; cb < NBLK; ++cb) bf[cb] = bfn[cb];
#pragma unroll
        for (int rb = 0; rb < 8; ++rb) af[rb] = afn[rb];
    }
    f32x4* part = (f32x4*)shm;
    __syncthreads();
#pragma unroll
    for (int rb = 0; rb < 8; ++rb)
#pragma unroll
        for (int cb = 0; cb < NBLK; ++cb) part[((wid * 8 + rb) * NBLK + cb) * 64 + lane] = acc[rb][cb];
    __syncthreads();
    f32x4 sum[NBLK];
#pragma unroll
    for (int cb = 0; cb < NBLK; ++cb) {
        f32x4 s = (f32x4){0.f, 0.f, 0.f, 0.f};
#pragma unroll
        for (int w = 0; w < 8; ++w) s += part[((w * 8 + wid) * NBLK + cb) * 64 + lane];
        sum[cb] = s;
    }
    fin(wid, sum, fr, fq);
    __syncthreads();
}
__device__ __forceinline__ u32x2 pack4(const f32x4 v) { u32x2 w; w.x = cvt_pk_bf16(v[0], v[1]); w.y = cvt_pk_bf16(v[2], v[3]); return w; }

#define SMALL_ITEMS(i, n) for (int i = (int)gridDim.x - 1 - (int)blockIdx.x; i < (n); i += (int)gridDim.x)

__device__ __forceinline__ void ph_ffn_in(const Params& p, unsigned char* shm, int widx) {
    const bf16_t* W = p.w_ffn_in[widx];
    SMALL_ITEMS(i, DFF / 16) {
        const int pn = (16 * i) >> 7, within = (16 * i) & 127;
        bf16_t* O = p.big;
        auto fin = [=](int rb, const f32x4 (&s)[2], int fr, int fq) {
            f32x4 y; for (int j = 0; j < 4; ++j) y[j] = silu_f(s[0][j]) * s[1][j];
            *(u32x2*)(O + (size_t)(MX + rb * 16 + fr) * DFF + 16 * i + fq * 4) = pack4(y); };
        small_gemm_item<2, false>(shm, p.hn + (size_t)MX * D, D, W + (size_t)(256 * pn + within) * D, W + (size_t)(256 * pn + 128 + within) * D, D, fin);
    }
    pg8::StaticOrder S; pg8::Gemm g{p.hn, W, MX, 2 * DFF, D, D}; S.init(g.M, g.N, gridDim.x, blockIdx.x);
    EpiSwiGLU E{p.big};
    if (S.split_tail()) {
        S.mode = 1; pg8::gemm_phase((LAS unsigned char*)shm, g, S, E);
        S.mode = 2;
        if (blockIdx.x & 1) pg8::gemm_phase<EpiSwiGLU, 2>((LAS unsigned char*)shm, g, S, E);
        else pg8::gemm_phase<EpiSwiGLU, 1>((LAS unsigned char*)shm, g, S, E);
    } else pg8::gemm_phase((LAS unsigned char*)shm, g, S, E);
}
template <bool HALFS, bool FINAL, bool BASEF32>
__device__ __forceinline__ void ph_resid(const Params& p, unsigned char* shm, const bf16_t* A, int lda, const bf16_t* Bt, int K, const float* base_x, const float* gain, int inst) {
    constexpr float scale = HALFS ? 0.5f : 1.0f;
    if (!FINAL) {
        unsigned* cmeta = p.xcnt + 6 * 64 * 64 + inst * 64;
        SMALL_ITEMS(i, D / 32) {
            float* H = p.hmeta;
            auto fin = [=](int rb, const f32x4 (&s)[2], int fr, int fq) {
#pragma unroll
                for (int cb = 0; cb < 2; ++cb) { float* hp = H + (size_t)(rb * 16 + fr) * D + 32 * i + cb * 16 + fq * 4; *(f32x4*)hp = *(const f32x4*)hp + scale * s[cb]; } };
            small_gemm_item<2, false>(shm, A + (size_t)MX * lda, lda, Bt + (size_t)(32 * i) * K, Bt + (size_t)(32 * i + 16) * K, K, fin);
            asm volatile("s_waitcnt vmcnt(0)" ::: "memory");
            __syncthreads();
            LAS unsigned* flag = (LAS unsigned*)shm;
            if (threadIdx.x == 0) {
                __builtin_amdgcn_fence(__ATOMIC_RELEASE, "agent");
                asm volatile("s_waitcnt vmcnt(0)" ::: "memory");
                const unsigned old = __hip_atomic_fetch_add(cmeta, 1u, __ATOMIC_RELAXED, __HIP_MEMORY_SCOPE_AGENT);
                const unsigned last = (old == (unsigned)(D / 32 - 1)) ? 1u : 0u;
                if (last) { __builtin_amdgcn_fence(__ATOMIC_ACQUIRE, "agent"); asm volatile("s_waitcnt vmcnt(0)" ::: "memory"); }
                *flag = last;
            }
            __syncthreads();
            if (*flag) {
                const int wid = threadIdx.x >> 6, lane = threadIdx.x & 63;
                f32x4 g[4];
#pragma unroll
                for (int q = 0; q < 4; ++q) g[q] = *(const f32x4*)(gain + q * 256 + lane * 4);
                f32x4 v[4], vn[4];
                { const float* s = p.hmeta + (size_t)(wid * 16) * D;
#pragma unroll
                  for (int q = 0; q < 4; ++q) v[q] = *(const f32x4*)(s + q * 256 + lane * 4); }
                for (int rr = 0; rr < 16; ++rr) {
                    const int row = wid * 16 + rr;
                    { const float* s = p.hmeta + (size_t)(rr < 15 ? row + 1 : row) * D;
#pragma unroll
                      for (int q = 0; q < 4; ++q) vn[q] = *(const f32x4*)(s + q * 256 + lane * 4); }
                    float ss = 0.f;
#pragma unroll
                    for (int q = 0; q < 4; ++q) ss += v[q][0] * v[q][0] + v[q][1] * v[q][1] + v[q][2] * v[q][2] + v[q][3] * v[q][3];
#pragma unroll
                    for (int o = 32; o >= 1; o >>= 1) ss += __shfl_xor(ss, o);
                    const float rstd = rsqrtf(ss * (1.0f / D) + RMS_EPS);
                    bf16_t* dst = p.hn + (size_t)(MX + row) * D;
#pragma unroll
                    for (int q = 0; q < 4; ++q) { const f32x4 y = v[q] * rstd * g[q]; u32x2 w; w.x = cvt_pk_bf16(y[0], y[1]); w.y = cvt_pk_bf16(y[2], y[3]); *(u32x2*)(dst + q * 256 + lane * 4) = w; }
#pragma unroll
                    for (int q = 0; q < 4; ++q) v[q] = vn[q];
                }
            }
            __syncthreads();
        }
    }
    pg8::StaticOrder S; pg8::Gemm g{A, Bt, MX, D, K, lda}; S.init(g.M, g.N, gridDim.x, blockIdx.x);
    EpiResidNorm<HALFS, FINAL, BASEF32> E{base_x, p.out, p.hn, gain, p.xbuf + (size_t)inst * 64 * 256 * 4, p.xcnt + inst * 64 * 64};
    pg8::gemm_phase((LAS unsigned char*)shm, g, S, E);
}
__device__ __forceinline__ void ph_da_qk(const Params& p, unsigned char* shm) {
    const bf16_t* Bt = p.w_da_qk; const DstDaQK dst{p.qd, p.kh};
    SMALL_ITEMS(i, 2048 / 32) {
        auto fin = [=](int rb, const f32x4 (&s)[2], int fr, int fq) {
#pragma unroll
            for (int cb = 0; cb < 2; ++cb) { const int c = 32 * i + cb * 16 + fq * 4;
                bf16_t* d = c < 1024 ? dst.Qd + (size_t)(MX + rb * 16 + fr) * 1024 + c : dst.Kh + ((size_t)(rb * 8 + ((c - 1024) >> 7)) * NTOK + fr) * 128 + (c & 127);
                *(u32x2*)d = pack4(s[cb]); } };
        small_gemm_item<2, false>(shm, p.hn + (size_t)MX * D, D, Bt + (size_t)(32 * i) * D, Bt + (size_t)(32 * i + 16) * D, D, fin);
    }
    pg8::StaticOrder S; pg8::Gemm g{p.hn, Bt, MX, 2048, D, D}; S.init(g.M, g.N, gridDim.x, blockIdx.x);
    EpiBf16T<DstDaQK> E{dst}; pg8::gemm_phase((LAS unsigned char*)shm, g, S, E);
}
__device__ __forceinline__ void ph_gla_main(const Params& p, unsigned char* shm) {
    const bf16_t* Bt = p.w_gla_main; const DstGlaMain dst{p.qh, p.g2};
    SMALL_ITEMS(i, 2048 / 32) {
        auto fin = [=](int rb, const f32x4 (&s)[2], int fr, int fq) {
#pragma unroll
            for (int cb = 0; cb < 2; ++cb) { const int c = 32 * i + cb * 16 + fq * 4;
                bf16_t* d = c < 512 ? dst.qh + ((size_t)(rb * 4 + (c >> 7)) * NTOK + fr) * 128 + (c & 127) : dst.g2 + (size_t)(MX + rb * 16 + fr) * 1536 + (c - 512);
                *(u32x2*)d = pack4(s[cb]); } };
        small_gemm_item<2, false>(shm, p.hn + (size_t)MX * D, D, Bt + (size_t)(32 * i) * D, Bt + (size_t)(32 * i + 16) * D, D, fin);
    }
    pg8::StaticOrder S; pg8::Gemm g{p.hn, Bt, MX, 2048, D, D}; S.init(g.M, g.N, gridDim.x, blockIdx.x);
    EpiBf16T<DstGlaMain> E{dst}; pg8::gemm_phase((LAS unsigned char*)shm, g, S, E);
}
__device__ __forceinline__ void ph_vt(unsigned char* shm, const bf16_t* Wv, const bf16_t* hn, bf16_t* vtc) {
    SMALL_ITEMS(i, 1024 / 32) {
        auto fin = [=](int rb, const f32x4 (&s)[2], int fr, int fq) {
#pragma unroll
            for (int cb = 0; cb < 2; ++cb) *(u32x2*)(vtc + ((size_t)(rb * 33) * 1024 + 32 * i + cb * 16 + fr) * 64 + fq * 4) = pack4(s[cb]); };
        small_gemm_item<2, true>(shm, hn + (size_t)MX * D, D, Wv + (size_t)(32 * i) * D, Wv + (size_t)(32 * i + 16) * D, D, fin);
    }
    pg8::StaticOrder S; pg8::Gemm g{Wv, hn, 1024, MX, D, D}; S.init(g.M, g.N, gridDim.x, blockIdx.x);
    EpiBf16T<DstVTc> E{DstVTc{vtc}}; pg8::gemm_phase((LAS unsigned char*)shm, g, S, E);
}
__device__ __forceinline__ void ph_glr(const Params& p, unsigned char* shm) {
    SMALL_ITEMS(i, MTOT / 128) {
        float* G = p.glr;
        auto fin = [=](int rb, const f32x4 (&s)[1], int fr, int fq) { *(f32x4*)(G + (size_t)(128 * i + rb * 16 + fr) * 16 + fq * 4) = s[0]; };
        const bf16_t* Wg = p.w_gla_main + (size_t)2048 * D;
        small_gemm_item<1, false>(shm, p.hn + (size_t)(128 * i) * D, D, Wg, Wg, D, fin);
    }
}

constexpr int NPHASES = 24;
#define XB_TMO      128
#define XB_XCNT(j)  (256  + 64 * (j))
#define XB_XSUB(j)  (1280 + 64 * (j))
#define XB_XGEN(j)  (2304 + 64 * (j))
#define XB_TOP      3328
#define XB_TOPGEN   3392
#define XCD_BAR_WORDS 3456
#define XB_SPIN_CAP (1u << 18)
__device__ __forceinline__ unsigned xb_ld(unsigned* p)              { return __hip_atomic_load(p, __ATOMIC_RELAXED, __HIP_MEMORY_SCOPE_AGENT); }
__device__ __forceinline__ unsigned xb_add(unsigned* p, unsigned v) { return __hip_atomic_fetch_add(p, v, __ATOMIC_RELAXED, __HIP_MEMORY_SCOPE_AGENT); }
__device__ __forceinline__ unsigned xb_xcc_id() { return (unsigned)__builtin_amdgcn_s_getreg((3 << 11) | 20) & 0xFu; }
#define XB_SPIN(cond, bar) do { unsigned _sp = 0; while (cond) { __builtin_amdgcn_s_sleep(1); \
    if ((++_sp & 255u) == 0u) { if (xb_ld(&(bar)[XB_TMO])) break; if (_sp > XB_SPIN_CAP) { atomicAdd(&(bar)[XB_TMO], 1u); break; } } } } while (0)
struct XcdBarrier { unsigned* bar; unsigned x; volatile LAS unsigned* st; };
__device__ __forceinline__ XcdBarrier xcd_barrier_post(unsigned* bar, volatile LAS unsigned* st) {
    XcdBarrier b; b.bar = bar; b.x = xb_xcc_id(); b.st = st;
    if (threadIdx.x == 0) (void)xb_add(&bar[XB_XCNT(b.x)], 1u);
    return b;
}
__device__ __forceinline__ void xcd_barrier_complete(unsigned* bar, unsigned x, unsigned& nloc, unsigned& nx) {
    const unsigned G = gridDim.x * gridDim.y * gridDim.z;
    unsigned sum, cnt, mine, sp = 0u;
    for (;;) {
        sum = 0u; cnt = 0u; mine = 0u;
#pragma unroll
        for (unsigned j = 0; j < 16; ++j) { const unsigned c = xb_ld(&bar[XB_XCNT(j)]); sum += c; cnt += (c > 0u) ? 1u : 0u; mine = (j == x) ? c : mine; }
        if (sum == G) break;
        __builtin_amdgcn_s_sleep(1);
        if ((++sp & 255u) == 0u) { if (xb_ld(&bar[XB_TMO])) break; if (sp > XB_SPIN_CAP) { atomicAdd(&bar[XB_TMO], 1u); break; } }
    }
    nloc = mine > 0u ? mine : 1u; nx = cnt > 0u ? cnt : 1u;
}
__device__ __attribute__((noinline)) void xcd_barrier(unsigned* barp) {
    extern __shared__ __attribute__((aligned(16))) unsigned char shm_xb[];
    XcdBarrier b; b.bar = barp; b.x = xb_xcc_id(); b.st = (volatile LAS unsigned*)((LAS unsigned char*)shm_xb + LDS_BYTES);
    asm volatile("s_waitcnt vmcnt(0)" ::: "memory");
    __syncthreads();
    if (threadIdx.x == 0) {
        unsigned* bar = b.bar;
        __builtin_amdgcn_s_waitcnt(0);
        unsigned nloc = b.st[0], nx = b.st[1];
        if (nloc == 0u) { xcd_barrier_complete(bar, b.x, nloc, nx); b.st[0] = nloc; b.st[1] = nx; }
        const unsigned old = xb_add(&bar[XB_XSUB(b.x)], 1u);
        const unsigned gen = old / nloc;
        if (old + 1u == (gen + 1u) * nloc) {
            __builtin_amdgcn_fence(__ATOMIC_RELEASE, "agent");
            asm volatile("s_waitcnt vmcnt(0)" ::: "memory");
            const unsigned og = xb_add(&bar[XB_TOP], 1u);
            const unsigned tg = og / nx;
            if (og + 1u == (tg + 1u) * nx) xb_add(&bar[XB_TOPGEN], 1u);
            else XB_SPIN(xb_ld(&bar[XB_TOPGEN]) == tg, bar);
            __builtin_amdgcn_fence(__ATOMIC_ACQUIRE, "agent");
            xb_add(&bar[XB_XGEN(b.x)], 1u);
            asm volatile("s_waitcnt vmcnt(0)" ::: "memory");
        } else {
            XB_SPIN(xb_ld(&bar[XB_XGEN(b.x)]) == gen, bar);
            __builtin_amdgcn_fence(__ATOMIC_ACQUIRE, "agent");
            asm volatile("s_waitcnt vmcnt(0)" ::: "memory");
        }
    }
    __syncthreads();
}
#ifndef PROBE_MASK
#define PROBE_MASK 0u
#endif
#define RUN(idx, ...) if (p.ph_lo <= (idx) && (idx) < p.ph_hi) { if ((PROBE_MASK >> (idx)) & 1u) { __VA_ARGS__; xcd_barrier(p.bar); } __VA_ARGS__; if ((idx) < 22 && (idx) + 1 < p.ph_hi) xcd_barrier(p.bar); }

__global__ void __launch_bounds__(512, 2) fwd_megakernel(const Params p) {
    extern __shared__ __attribute__((aligned(16))) unsigned char shm[];
    cg::grid_group grid = cg::this_grid();
    if (p.ph_hi > 1000) grid.sync();
    volatile LAS unsigned* xst = (volatile LAS unsigned*)((LAS unsigned char*)shm + LDS_BYTES);
    if (threadIdx.x == 0) { xst[0] = 0u; xst[1] = 0u; }
    __syncthreads();
    (void)xcd_barrier_post(p.bar, xst);
    RUN(0, prep_phase(p, shm); norm_phase(p, p.x, p.ffn1_norm, false, true))
    RUN(2, ph_ffn_in(p, shm, 0))
    RUN(3, (ph_resid<true, false, true>(p, shm, p.big, DFF, p.w_ffn_out[0], DFF, p.x, p.mix_norm, 0)))
    RUN(5, ph_da_qk(p, shm); ph_vt(shm, p.w_da_v, p.hn, p.vtc_da))
    RUN(6, attn_phase(p, shm))
    RUN(7, (ph_resid<false, false, false>(p, shm, p.qd, D, p.w_da_out, D, p.out, p.ffn2_norm, 1)))
    RUN(9, ph_ffn_in(p, shm, 1))
    RUN(10, (ph_resid<true, false, false>(p, shm, p.big, DFF, p.w_ffn_out[1], DFF, p.out, p.ffn1_norm + D, 2)))
    RUN(12, ph_ffn_in(p, shm, 2))
    RUN(13, (ph_resid<true, false, false>(p, shm, p.big, DFF, p.w_ffn_out[2], DFF, p.out, p.mix_norm + D, 3)))
    RUN(15, ph_glr(p, shm); ph_gla_main(p, shm); ph_vt(shm, p.w_gla_v, p.hn, p.vtc_gla))
    RUN(16, gla_prep_phase(p, shm))
    RUN(17, gla_scan_phase(p, shm))
    RUN(18, gla_post_phase(p))
    RUN(19, (ph_resid<false, false, false>(p, shm, p.g2 + 512, 1536, p.w_gla_out, D, p.out, p.ffn2_norm + D, 4)))
    RUN(21, ph_ffn_in(p, shm, 3))
    RUN(22, (ph_resid<true, true, false>(p, shm, p.big, DFF, p.w_ffn_out[3], DFF, p.out, p.final_norm, 5)))
}

#ifndef N_LAUNCH_MODE
#define N_LAUNCH_MODE 0
#endif

extern "C" void kernel_launch(void* const* d_in, const int* in_sizes, int n_in, void* d_out, int out_size, void* d_ws, size_t ws_size, hipStream_t stream) {
    (void)in_sizes; (void)n_in; (void)out_size;
    Params p; memset(&p, 0, sizeof(p));
    const float* x = (const float*)d_in[0];
    p.x = x; p.meta = (const float*)d_in[1]; p.ffn1_norm = (const float*)d_in[2];
    const float* ffn1_w_in = (const float*)d_in[3]; const float* ffn1_w_out = (const float*)d_in[4];
    p.mix_norm = (const float*)d_in[5]; p.ffn2_norm = (const float*)d_in[6];
    const float* ffn2_w_in = (const float*)d_in[7]; const float* ffn2_w_out = (const float*)d_in[8];
    const float* da_w_in = (const float*)d_in[9]; p.da_lambda = (const float*)d_in[10]; p.da_subln = (const float*)d_in[11];
    const float* da_w_out = (const float*)d_in[12]; const float* gla_w_in = (const float*)d_in[13];
    p.gla_w_gate2 = (const float*)d_in[14]; p.gla_b_gate2 = (const float*)d_in[15]; p.gla_norm = (const float*)d_in[16];
    const float* gla_w_out = (const float*)d_in[17]; p.final_norm = (const float*)d_in[18];
    p.out = (float*)d_out;

    char* ws = (char*)d_ws; size_t off = 0;
    auto take = [&](size_t bytes) { char* r = ws + off; off += (bytes + 255) & ~(size_t)255; return r; };
    for (int i = 0; i < 4; ++i) p.w_ffn_in[i] = (bf16_t*)take((size_t)2 * DFF * D * 2);
    for (int i = 0; i < 4; ++i) p.w_ffn_out[i] = (bf16_t*)take((size_t)D * DFF * 2);
    p.w_da_qk = (bf16_t*)take((size_t)2048 * D * 2); p.w_da_v = (bf16_t*)take((size_t)1024 * D * 2); p.w_da_out = (bf16_t*)take((size_t)1024 * D * 2);
    p.w_gla_main = (bf16_t*)take((size_t)2304 * D * 2); p.w_gla_v = (bf16_t*)take((size_t)1024 * D * 2); p.w_gla_out = (bf16_t*)take((size_t)1024 * D * 2);
    p.big = (bf16_t*)take((size_t)51314688 * 2);
    p.qd = p.big; p.kh = p.big + (size_t)MP * 1024; p.vtc_da = p.kh + (size_t)64 * NTOK * 128;
    p.g2 = p.big; p.qh = p.big + (size_t)MP * 1536; p.vtc_gla = p.qh + (size_t)32 * NTOK * 128;
    p.hn = (bf16_t*)take((size_t)MP * D * 2);
    p.kdecT = (bf16_t*)take((size_t)NB * 33 * 512 * 64 * 2);
    p.hmeta = (float*)take((size_t)256 * D * 4);
    p.glr = (float*)take((size_t)MP * 16 * 4);
    p.decay = (float*)take((size_t)NB * 33 * 512 * 4);
    p.bar = (unsigned*)take((size_t)(XCD_BAR_WORDS + XCNT_WORDS) * 4); p.xcnt = p.bar + XCD_BAR_WORDS;
    p.xbuf = (float*)take((size_t)6 * 64 * 256 * 4 * 4);
    if (off > ws_size) { fprintf(stderr, "workspace too small: need %zu have %zu\n", off, ws_size); return; }

    int nj = 0, tiles = 0;
    auto add = [&](const float* src, bf16_t* dst, int ldw, int K, int ndst, int col0, int mode, int nvalid) {
        Job& j = p.jobs[nj++]; j.src = src; j.dst = dst; j.ldw = ldw; j.K = K; j.ndst = ndst; j.col0 = col0; j.mode = mode; j.nvalid = nvalid; j.tile0 = tiles; j.pad = 0;
        tiles += (K / 128) * (ndst / 128); };
    add(ffn1_w_in, p.w_ffn_in[0], 2 * DFF, D, 2 * DFF, 0, 1, 2 * DFF);
    add(ffn2_w_in, p.w_ffn_in[1], 2 * DFF, D, 2 * DFF, 0, 1, 2 * DFF);
    add(ffn1_w_in + (size_t)D * 2 * DFF, p.w_ffn_in[2], 2 * DFF, D, 2 * DFF, 0, 1, 2 * DFF);
    add(ffn2_w_in + (size_t)D * 2 * DFF, p.w_ffn_in[3], 2 * DFF, D, 2 * DFF, 0, 1, 2 * DFF);
    add(ffn1_w_out, p.w_ffn_out[0], D, DFF, D, 0, 0, D);
    add(ffn2_w_out, p.w_ffn_out[1], D, DFF, D, 0, 0, D);
    add(ffn1_w_out + (size_t)DFF * D, p.w_ffn_out[2], D, DFF, D, 0, 0, D);
    add(ffn2_w_out + (size_t)DFF * D, p.w_ffn_out[3], D, DFF, D, 0, 0, D);
    add(da_w_in, p.w_da_qk, 3072, D, 2048, 0, 0, 2048);
    add(da_w_in, p.w_da_v, 3072, D, 1024, 2048, 0, 1024);
    add(da_w_out, p.w_da_out, D, D, D, 0, 0, D);
    add(gla_w_in, p.w_gla_main, 3088, D, 1024, 0, 0, 1024);
    add(gla_w_in, p.w_gla_main + (size_t)1024 * D, 3088, D, 1024, 2048, 0, 1024);
    add(gla_w_in, p.w_gla_main + (size_t)2048 * D, 3088, D, 256, 3072, 0, 16);
    add(gla_w_in, p.w_gla_v, 3088, D, 1024, 1024, 0, 1024);
    add(gla_w_out, p.w_gla_out, D, D, D, 0, 0, D);
    p.njobs = nj; p.ntiles_prep = tiles;

    static int grid_blocks = 0;
    if (!grid_blocks) {
        (void)hipFuncSetAttribute((const void*)fwd_megakernel, hipFuncAttributeMaxDynamicSharedMemorySize, LDS_TOTAL);
        int dev = 0, cus = 0, per_cu = 0;
        (void)hipGetDevice(&dev);
        (void)hipDeviceGetAttribute(&cus, hipDeviceAttributeMultiprocessorCount, dev);
        (void)hipOccupancyMaxActiveBlocksPerMultiprocessor(&per_cu, fwd_megakernel, 512, LDS_TOTAL);
        if (per_cu > 1) per_cu = 1;
        grid_blocks = cus * per_cu;
        if (grid_blocks <= 0) grid_blocks = 256;
    }
#if N_LAUNCH_MODE == 1
    for (int ph = 0; ph < NPHASES; ++ph) {
        p.ph_lo = ph; p.ph_hi = ph + 1;
        hipLaunchKernelGGL(fwd_megakernel, dim3(grid_blocks), dim3(512), LDS_TOTAL, stream, p);
    }
#else
    p.ph_lo = 0; p.ph_hi = NPHASES;
    (void)hipMemsetAsync(p.bar, 0, (size_t)XCD_BAR_WORDS * 4, stream);
    void* args[] = {(void*)&p};
    hipError_t e = hipLaunchCooperativeKernel((const void*)fwd_megakernel, dim3(grid_blocks), dim3(512), args, LDS_TOTAL, stream);
    if (e != hipSuccess) fprintf(stderr, "cooperative launch failed: %s (grid %d)\n", hipGetErrorString(e), grid_blocks);
#endif
}
```

```cpp
#include <hip/hip_runtime.h>
#include <hip/hip_cooperative_groups.h>
#include <cstdio>
#include <cstring>
namespace cg = cooperative_groups;

#define LAS __attribute__((address_space(3)))
typedef unsigned short bf16_t;
typedef short bf16x8 __attribute__((ext_vector_type(8)));
typedef float f32x4 __attribute__((ext_vector_type(4)));
typedef float f32x2 __attribute__((ext_vector_type(2)));
typedef unsigned u32x4 __attribute__((ext_vector_type(4)));
typedef unsigned u32x2 __attribute__((ext_vector_type(2)));

constexpr int D = 1024, NB = 8, SEQ = 2048, DFF = 2816;
constexpr int MX = NB * SEQ;
constexpr int MMETA = NB * 16;
constexpr int MTOT = MX + MMETA;
constexpr int MP = 16640;
constexpr int LDS_BYTES = 131072;
constexpr int LDS_TOTAL = LDS_BYTES + 16;
constexpr float RMS_EPS = 1e-6f;
#define XCNT_WORDS (6 * 64 * 64 + 6 * 64)

typedef __bf16 bf16x2_t __attribute__((ext_vector_type(2)));
__device__ __forceinline__ unsigned cvt_pk_bf16(float lo, float hi) { const f32x2 v = {lo, hi}; const bf16x2_t b = __builtin_convertvector(v, bf16x2_t); return __builtin_bit_cast(unsigned, b); }
__device__ __forceinline__ void store_wt16(void* p, u32x4 v) { asm volatile("global_store_dwordx4 %0, %1, off sc1\n\ts_nop 1" :: "v"(p), "v"(v) : "memory"); }
__device__ __forceinline__ float bf2f(unsigned short b) { return __uint_as_float(((unsigned)b) << 16); }
__device__ __forceinline__ float bflo(unsigned w) { return __uint_as_float(w << 16); }
__device__ __forceinline__ float bfhi(unsigned w) { return __uint_as_float(w & 0xffff0000u); }

namespace pg8 {
constexpr int BM = 256, BK = 64, HALF = 128, HTB = HALF * BK * 2, STAGE_BYTES = 8 * HTB, NXCD = 8, WGM = 8;
__host__ __device__ __forceinline__ int lds_byte(int r, int c) { const int st = (r >> 4) * 2 + (c >> 5), rr = r & 15, cc = c & 31, ob = rr * 64 + cc * 2; return st * 1024 + (ob ^ (((ob >> 9) & 1) << 5)); }
__host__ __device__ __forceinline__ void stage_rc(int b, int& R, int& C) { const int st = b / 1024, sb = b % 1024, swz = sb ^ (((sb >> 9) & 1) << 5); R = (st >> 1) * 16 + swz / 64; C = (st & 1) * 32 + (swz % 64) / 2; }
__host__ __device__ __forceinline__ int perm32(int rho) { const int n = rho >> 4, i = rho & 15; return 8 * (i >> 2) + 4 * n + (i & 3); }

struct Unit { int pm, pn; };
struct Gemm { const bf16_t* A; const bf16_t* Bt; int M, N, K, lda; };
struct StaticOrder {
    int nM, nN, nwg, G, c, mode;
    __device__ void init(int M, int N, int G_, int c_, int mode_ = 0) { nM = M / BM; nN = N / BM; nwg = nM * nN; G = G_; c = c_; mode = mode_; }
    __device__ bool split_tail() const { const int rem = nwg % G; return rem > 0 && 2 * rem <= G; }
    __device__ bool next(int i, Unit& u) const {
        long L;
        if (mode == 2) { const int full = nwg / G, rem = nwg - full * G; if (i != 0 || c >= 2 * rem) return false; L = (long)full * G + (c >> 1); }
        else { L = (long)i * G + c; if (L >= nwg) return false; if (mode == 1 && i >= nwg / G) return false; }
        int wgid = (int)L; { const int q = nwg / NXCD, r = nwg % NXCD, xcd = wgid % NXCD, off = wgid / NXCD; wgid = (xcd < r ? xcd * (q + 1) : r * (q + 1) + (xcd - r) * q) + off; }
        const int nig = WGM * nN, gid = wgid / nig, fm = gid * WGM, gsz = (nM - fm) < WGM ? (nM - fm) : WGM;
        u.pm = fm + ((wgid % nig) % gsz); u.pn = (wgid % nig) / gsz; return true;
    }
};

template <class Epi, int HSEL = 0>
__device__ __forceinline__ void gemm_phase(LAS unsigned char* lds, const Gemm g, const StaticOrder& S, const Epi& E) {
    const int tid = threadIdx.x, wid = __builtin_amdgcn_readfirstlane(tid >> 6), lane = tid & 63, wr = wid >> 2, wc = wid & 3, fr = lane & 15, fq = lane >> 4;
    const int K = g.K, nt = K / BK;
    unsigned voffA[2], voffB[2];
#pragma unroll
    for (int i = 0; i < 2; ++i) { int R, C; stage_rc(tid * 16 + i * 8192, R, C); const int Rb = Epi::PERM ? ((R & ~31) + perm32(R & 31)) : R;
        voffA[i] = (unsigned)(R * g.lda + C) * 2u; voffB[i] = (unsigned)(Rb * K + C) * 2u; }
    const size_t kstep = (size_t)(BK * 2);
    const size_t hstep = (size_t)HALF * K * 2, hstepA = (size_t)HALF * g.lda * 2;
    const size_t tstep = 2 * hstep, tstepA = 2 * hstepA;
    const unsigned ldsw = (unsigned)wid * 1024u;
    const int aoff = lds_byte(wr * 64 + fr, fq * 8), boff = lds_byte(wc * 32 + fr, fq * 8);
#define PG8_SA(b, h) (((b) * 2 + (h)) * HTB)
#define PG8_SB(b, h) ((4 + (b) * 2 + (h)) * HTB)
#define PG8_STAGE(bufoff, gbase, voff) do { _Pragma("unroll") for (int _i = 0; _i < 2; ++_i) \
        __builtin_amdgcn_global_load_lds((const unsigned*)((const char*)(gbase) + (voff)[_i]), (LAS unsigned*)(lds + (bufoff) + ldsw + _i * 8192), 16, 0, 0); } while (0)
#define PG8_LDA(dst, b, h) do { _Pragma("unroll") for (int m = 0; m < 4; ++m) _Pragma("unroll") for (int k = 0; k < 2; ++k) dst[m][k] = *(const LAS bf16x8*)(lds + PG8_SA(b, h) + aoff + m * 2048 + k * 1024); } while (0)
#define PG8_LDB(dst, b, h) do { _Pragma("unroll") for (int n = 0; n < 2; ++n) _Pragma("unroll") for (int k = 0; k < 2; ++k) dst[n][k] = *(const LAS bf16x8*)(lds + PG8_SB(b, h) + boff + n * 2048 + k * 1024); } while (0)
#define PG8_MMA(ai, bj, At, Bt) do { __builtin_amdgcn_s_setprio(1); _Pragma("unroll") for (int m = 0; m < 4; ++m) _Pragma("unroll") for (int n = 0; n < 2; ++n) _Pragma("unroll") for (int k = 0; k < 2; ++k) \
        acc[ai][bj][m][n] = __builtin_amdgcn_mfma_f32_16x16x32_bf16(Bt[n][k], At[m][k], acc[ai][bj][m][n], 0, 0, 0); __builtin_amdgcn_s_setprio(0); } while (0)
#define PG8_KEEPA(X) do { _Pragma("unroll") for (int m = 0; m < 4; ++m) _Pragma("unroll") for (int k = 0; k < 2; ++k) asm volatile("" :: "v"(X[m][k])); } while (0)
#define PG8_WAIT_V(n) asm volatile("s_waitcnt vmcnt(" #n ")" ::: "memory")
#define PG8_WAIT_L(n) asm volatile("s_waitcnt lgkmcnt(" #n ")" ::: "memory")
#define PG8_BAR __builtin_amdgcn_s_barrier()
#define PG8_SCHED __builtin_amdgcn_sched_barrier(0)
    Unit cur, nxt; int ui = 0;
    if (!S.next(0, cur)) return;
    f32x4 acc[2][2][4][2];
#pragma unroll
    for (int a = 0; a < 2; ++a)
#pragma unroll
        for (int b = 0; b < 2; ++b)
#pragma unroll
            for (int m = 0; m < 4; ++m)
#pragma unroll
                for (int n = 0; n < 2; ++n) acc[a][b][m][n] = (f32x4){0.f, 0.f, 0.f, 0.f};
    bf16x8 At[4][2], B0[2][2], B1[2][2];
    const char* cA = (const char*)g.A + (size_t)cur.pm * tstepA; const char* cB = (const char*)g.Bt + (size_t)cur.pn * tstep;
    PG8_STAGE(PG8_SB(0, 0), cB, voffB); PG8_STAGE(PG8_SA(0, 0), cA, voffA); PG8_STAGE(PG8_SB(0, 1), cB + hstep, voffB); PG8_STAGE(PG8_SA(0, 1), cA + hstepA, voffA);
    if (wr == 1) PG8_BAR;
    PG8_WAIT_V(4); PG8_BAR;
    PG8_STAGE(PG8_SB(1, 0), cB + kstep, voffB); PG8_STAGE(PG8_SA(1, 0), cA + kstep, voffA); PG8_STAGE(PG8_SB(1, 1), cB + hstep + kstep, voffB);
    PG8_WAIT_V(6); PG8_BAR;
    for (;;) {
        const bool has_next = S.next(ui + 1, nxt);
        const char* nA = has_next ? (const char*)g.A + (size_t)nxt.pm * tstepA : cA; const char* nB = has_next ? (const char*)g.Bt + (size_t)nxt.pn * tstep : cB;
        for (int t = 0; t < nt; t += 2) {
            const bool last = (t == nt - 2);
            const char* a1 = cA + (size_t)(t + 1) * kstep;
            const char* a2 = last ? nA : cA + (size_t)(t + 2) * kstep; const char* b2 = last ? nB : cB + (size_t)(t + 2) * kstep;
            const char* a3 = a2 + kstep; const char* b3 = b2 + kstep;
            PG8_LDB(B0, 0, 0); PG8_SCHED; PG8_LDA(At, 0, 0); PG8_STAGE(PG8_SA(1, 1), a1 + hstepA, voffA);
            PG8_WAIT_L(8); PG8_BAR; PG8_WAIT_L(0); if (HSEL != 2) PG8_MMA(0, 0, At, B0); else PG8_KEEPA(At); PG8_BAR; PG8_SCHED;
            PG8_LDB(B1, 0, 1); PG8_STAGE(PG8_SB(0, 0), b2, voffB);
            PG8_BAR; PG8_WAIT_L(0); if (HSEL != 2) PG8_MMA(0, 1, At, B1); else PG8_KEEPA(At); PG8_BAR;
            PG8_LDA(At, 0, 1); PG8_STAGE(PG8_SA(0, 0), a2, voffA);
            PG8_BAR; PG8_WAIT_L(0); if (HSEL != 1) PG8_MMA(1, 0, At, B0); else PG8_KEEPA(At); PG8_BAR; PG8_SCHED;
            PG8_STAGE(PG8_SB(0, 1), b2 + hstep, voffB);
            PG8_WAIT_V(6); PG8_BAR; if (HSEL != 1) PG8_MMA(1, 1, At, B1); else PG8_KEEPA(At); PG8_BAR;
            PG8_LDB(B0, 1, 0); PG8_SCHED; PG8_LDA(At, 1, 0); PG8_STAGE(PG8_SA(0, 1), a2 + hstepA, voffA);
            PG8_WAIT_L(8); PG8_BAR; PG8_WAIT_L(0); if (HSEL != 2) PG8_MMA(0, 0, At, B0); else PG8_KEEPA(At); PG8_BAR; PG8_SCHED;
            PG8_LDB(B1, 1, 1); PG8_STAGE(PG8_SB(1, 0), b3, voffB);
            PG8_BAR; PG8_WAIT_L(0); if (HSEL != 2) PG8_MMA(0, 1, At, B1); else PG8_KEEPA(At); PG8_BAR;
            PG8_LDA(At, 1, 1); PG8_STAGE(PG8_SA(1, 0), a3, voffA);
            PG8_BAR; PG8_WAIT_L(0); if (HSEL != 1) PG8_MMA(1, 0, At, B0); else PG8_KEEPA(At); PG8_BAR; PG8_SCHED;
            PG8_STAGE(PG8_SB(1, 1), b3 + hstep, voffB);
            PG8_WAIT_V(6); PG8_BAR; if (HSEL != 1) PG8_MMA(1, 1, At, B1); else PG8_KEEPA(At); PG8_BAR;
        }
        if constexpr (!Epi::AFTER_DRAIN) E(acc, cur, wr, wc, fr, fq, HSEL);
        if (!has_next) break;
#pragma unroll
        for (int a = 0; a < 2; ++a)
#pragma unroll
            for (int b = 0; b < 2; ++b)
#pragma unroll
                for (int m = 0; m < 4; ++m)
#pragma unroll
                    for (int n = 0; n < 2; ++n) acc[a][b][m][n] = (f32x4){0.f, 0.f, 0.f, 0.f};
        cur = nxt; cA = nA; cB = nB; ++ui;
    }
    PG8_WAIT_V(0);
    if (wr == 0) PG8_BAR;
    PG8_BAR;
    if constexpr (Epi::AFTER_DRAIN) E.fused(acc, cur, wr, wc, fr, fq, lds, wid, lane);
#undef PG8_SA
#undef PG8_SB
#undef PG8_STAGE
#undef PG8_LDA
#undef PG8_LDB
#undef PG8_MMA
#undef PG8_KEEPA
#undef PG8_WAIT_V
#undef PG8_WAIT_L
#undef PG8_BAR
#undef PG8_SCHED
}
}
using pg8::Unit;

__device__ __forceinline__ float silu_f(float g) { return g * __builtin_amdgcn_rcpf(1.0f + __expf(-g)); }

struct EpiSwiGLU {
    static constexpr bool PERM = true, AFTER_DRAIN = false;
    bf16_t* O;
    __device__ __forceinline__ void operator()(const f32x4 (&acc)[2][2][4][2], const Unit& u, int wr, int wc, int fr, int fq, int half) const {
        const int row0 = u.pm * 256 + wr * 64 + fr, col0 = u.pn * 128 + wc * 32 + 8 * fq;
#pragma unroll
        for (int ai = 0; ai < 2; ++ai) {
            if (half == 2 - ai) continue;
#pragma unroll
            for (int m = 0; m < 4; ++m) {
                bf16_t* rowp = O + (size_t)(row0 + ai * 128 + m * 16) * DFF + col0;
                const f32x4 g0 = acc[ai][0][m][0], g1 = acc[ai][0][m][1], u0 = acc[ai][1][m][0], u1 = acc[ai][1][m][1];
                u32x4 w;
                w.x = cvt_pk_bf16(silu_f(g0[0]) * u0[0], silu_f(g0[1]) * u0[1]); w.y = cvt_pk_bf16(silu_f(g0[2]) * u0[2], silu_f(g0[3]) * u0[3]);
                w.z = cvt_pk_bf16(silu_f(g1[0]) * u1[0], silu_f(g1[1]) * u1[1]); w.w = cvt_pk_bf16(silu_f(g1[2]) * u1[2], silu_f(g1[3]) * u1[3]);
                store_wt16(rowp, w);
            }
        }
    }
};
struct EpiResid {
    static constexpr bool PERM = false, AFTER_DRAIN = false;
    const float* base_x; float* out_x; float scale;
    __device__ __forceinline__ void operator()(const f32x4 (&acc)[2][2][4][2], const Unit& u, int wr, int wc, int fr, int fq, int half) const {
        const int col0 = u.pn * 256 + wc * 32 + 4 * fq;
        const int row0 = u.pm * 256 + wr * 64 + fr;
#pragma unroll
        for (int ai = 0; ai < 2; ++ai) {
            if (half == 2 - ai) continue;
#pragma unroll
            for (int m = 0; m < 4; ++m) {
                const size_t off = (size_t)(row0 + ai * 128 + m * 16) * D + col0;
#pragma unroll
                for (int bj = 0; bj < 2; ++bj)
#pragma unroll
                    for (int n = 0; n < 2; ++n) {
                        const f32x4 b = *(const f32x4*)(base_x + off + bj * 128 + n * 16);
                        *(f32x4*)(out_x + off + bj * 128 + n * 16) = b + scale * acc[ai][bj][m][n];
                    }
            }
        }
    }
};
__device__ __forceinline__ bf16_t* hb_ptr(float* out, int r, int c) { return (bf16_t*)out + ((size_t)(r >> 8) * (256 * 1024 * 2) + (size_t)(r & 255) * 1024 + c); }
template <bool HALFS, bool FINAL, bool BASEF32> struct EpiResidNorm {
    static constexpr bool PERM = true, AFTER_DRAIN = true;
    const float* base_x; float* out_x; bf16_t* hn; const float* gain; float* xbuf; unsigned* cnt;
    __device__ __forceinline__ void fused(f32x4 (&acc)[2][2][4][2], const Unit& u, int wr, int wc, int fr, int fq, LAS unsigned char* lds, int wid, int lane) const {
        constexpr float scale = HALFS ? 0.5f : 1.0f;
        LAS float* P = (LAS float*)lds;
        LAS float* S = (LAS float*)(lds + 4096);
        const int col0 = u.pn * 256 + wc * 32 + 8 * fq, rt0 = wr * 64 + fr, tid = wid * 64 + lane;
#pragma unroll
        for (int ai = 0; ai < 2; ++ai)
#pragma unroll
            for (int m = 0; m < 4; ++m) {
                const int rt = rt0 + ai * 128 + m * 16, r = u.pm * 256 + rt;
                float ss = 0.f;
#pragma unroll
                for (int bj = 0; bj < 2; ++bj) {
                    f32x4 b0, b1;
                    if (BASEF32) { const float* bp = base_x + (size_t)r * D + col0 + bj * 128; b0 = __builtin_nontemporal_load((const f32x4*)bp); b1 = __builtin_nontemporal_load((const f32x4*)(bp + 4)); }
                    else { const u32x4 w = *(const u32x4*)hb_ptr(out_x, r, col0 + bj * 128); b0 = (f32x4){bflo(w.x), bfhi(w.x), bflo(w.y), bfhi(w.y)}; b1 = (f32x4){bflo(w.z), bfhi(w.z), bflo(w.w), bfhi(w.w)}; }
                    const f32x4 v0 = b0 + scale * acc[ai][bj][m][0], v1 = b1 + scale * acc[ai][bj][m][1];
                    acc[ai][bj][m][0] = v0; acc[ai][bj][m][1] = v1;
                    ss += (v0[0] * v0[0] + v0[1] * v0[1] + v0[2] * v0[2] + v0[3] * v0[3]) + (v1[0] * v1[0] + v1[1] * v1[1] + v1[2] * v1[2] + v1[3] * v1[3]);
                }
                ss += __shfl_xor(ss, 16); ss += __shfl_xor(ss, 32);
                if (fq == 0) P[rt * 4 + wc] = ss;
                if (BASEF32 || m == 3) asm volatile("" ::: "memory");
            }
        asm volatile("s_waitcnt lgkmcnt(0)" ::: "memory"); __builtin_amdgcn_s_barrier(); asm volatile("" ::: "memory");
        if (tid < 256) {
            const f32x4 q = *(const LAS f32x4*)(P + tid * 4);
            __hip_atomic_store(xbuf + ((size_t)u.pm * 256 + tid) * 4 + u.pn, (q[0] + q[1]) + (q[2] + q[3]), __ATOMIC_RELAXED, __HIP_MEMORY_SCOPE_AGENT);
        }
        asm volatile("s_waitcnt vmcnt(0)" ::: "memory");
        if (tid < 256 && lane == 0) __hip_atomic_fetch_add(cnt + 64 * u.pm, 1u, __ATOMIC_RELAXED, __HIP_MEMORY_SCOPE_AGENT);
        if (wid == 0) {
            unsigned sp = 0;
            while ((unsigned)__builtin_amdgcn_readfirstlane(__hip_atomic_load(cnt + 64 * u.pm, __ATOMIC_RELAXED, __HIP_MEMORY_SCOPE_AGENT)) < 16u) { __builtin_amdgcn_s_sleep(1); if (++sp > (1u << 21)) break; }
            __builtin_amdgcn_fence(__ATOMIC_ACQUIRE, "agent");
            asm volatile("s_waitcnt vmcnt(0)" ::: "memory");
        }
        asm volatile("s_waitcnt vmcnt(0) lgkmcnt(0)" ::: "memory"); __builtin_amdgcn_s_barrier(); asm volatile("" ::: "memory");
        if (tid < 256) {
            const float* slot = xbuf + ((size_t)u.pm * 256 + tid) * 4;
            const float a = __hip_atomic_load(slot + 0, __ATOMIC_RELAXED, __HIP_MEMORY_SCOPE_AGENT), b = __hip_atomic_load(slot + 1, __ATOMIC_RELAXED, __HIP_MEMORY_SCOPE_AGENT);
            const float c = __hip_atomic_load(slot + 2, __ATOMIC_RELAXED, __HIP_MEMORY_SCOPE_AGENT), d = __hip_atomic_load(slot + 3, __ATOMIC_RELAXED, __HIP_MEMORY_SCOPE_AGENT);
            S[tid] = rsqrtf(((a + b) + (c + d)) * (1.0f / D) + RMS_EPS);
        }
        asm volatile("s_waitcnt lgkmcnt(0)" ::: "memory"); __builtin_amdgcn_s_barrier(); asm volatile("" ::: "memory");
        f32x4 g[2][2];
#pragma unroll
        for (int bj = 0; bj < 2; ++bj)
#pragma unroll
            for (int n = 0; n < 2; ++n) g[bj][n] = *(const f32x4*)(gain + col0 + bj * 128 + n * 4);
#pragma unroll
        for (int ai = 0; ai < 2; ++ai)
#pragma unroll
            for (int m = 0; m < 4; ++m) {
                const int rt = rt0 + ai * 128 + m * 16;
                const size_t off = (size_t)(u.pm * 256 + rt) * D + col0;
                const float rs = S[rt];
#pragma unroll
                for (int bj = 0; bj < 2; ++bj) {
                    const f32x4 y0 = acc[ai][bj][m][0] * rs * g[bj][0], y1 = acc[ai][bj][m][1] * rs * g[bj][1];
                    if (FINAL) { __builtin_nontemporal_store(y0, (f32x4*)(out_x + off + bj * 128)); __builtin_nontemporal_store(y1, (f32x4*)(out_x + off + bj * 128 + 4)); }
                    else { u32x4 w; w.x = cvt_pk_bf16(y0[0], y0[1]); w.y = cvt_pk_bf16(y0[2], y0[3]); w.z = cvt_pk_bf16(y1[0], y1[1]); w.w = cvt_pk_bf16(y1[2], y1[3]); store_wt16(hn + off + bj * 128, w);
                           const f32x4 v0 = acc[ai][bj][m][0], v1 = acc[ai][bj][m][1];
                           u32x4 hw; hw.x = cvt_pk_bf16(v0[0], v0[1]); hw.y = cvt_pk_bf16(v0[2], v0[3]); hw.z = cvt_pk_bf16(v1[0], v1[1]); hw.w = cvt_pk_bf16(v1[2], v1[3]); store_wt16(hb_ptr(out_x, u.pm * 256 + rt, col0 + bj * 128), hw); }
                }
                asm volatile("" ::: "memory");
            }
    }
};
template <class Dst> struct EpiBf16T {
    static constexpr bool PERM = true, AFTER_DRAIN = false;
    Dst dst;
    __device__ __forceinline__ void operator()(const f32x4 (&acc)[2][2][4][2], const Unit& u, int wr, int wc, int fr, int fq, int half) const {
        const int row0 = u.pm * 256 + wr * 64 + fr, cw = wc * 32 + 8 * fq;
#pragma unroll
        for (int ai = 0; ai < 2; ++ai) {
            if (half == 2 - ai) continue;
#pragma unroll
            for (int m = 0; m < 4; ++m) {
                const int r = row0 + ai * 128 + m * 16;
#pragma unroll
                for (int bj = 0; bj < 2; ++bj) {
                    const f32x4 v0 = acc[ai][bj][m][0], v1 = acc[ai][bj][m][1];
                    u32x4 w; w.x = cvt_pk_bf16(v0[0], v0[1]); w.y = cvt_pk_bf16(v0[2], v0[3]); w.z = cvt_pk_bf16(v1[0], v1[1]); w.w = cvt_pk_bf16(v1[2], v1[3]);
                    store_wt16(dst(r, u.pn, bj, cw), w);
                }
            }
        }
    }
};
constexpr int NTOK = 16 + SEQ;
struct DstDaQK { bf16_t* Qd; bf16_t* Kh;
    __device__ __forceinline__ bf16_t* operator()(int r, int pn, int bj, int cw) const {
        if (pn < 4) return Qd + (size_t)r * 1024 + pn * 256 + bj * 128 + cw;
        const int b = r >> 11, s = r & 2047, h = 2 * (pn - 4) + bj;
        return Kh + ((size_t)(b * 8 + h) * NTOK + 16 + s) * 128 + cw; } };
struct DstGlaMain { bf16_t* qh; bf16_t* g2;
    __device__ __forceinline__ bf16_t* operator()(int r, int pn, int bj, int cw) const {
        if (pn >= 2) return g2 + (size_t)r * 1536 + (pn - 2) * 256 + bj * 128 + cw;
        const int b = r >> 11, s = r & 2047, h = 2 * pn + bj;
        return qh + ((size_t)(b * 4 + h) * NTOK + 16 + s) * 128 + cw; } };
struct DstVTc { bf16_t* vtc;
    __device__ __forceinline__ bf16_t* operator()(int f, int pn, int bj, int cw) const {
        const int tok = pn * 256 + bj * 128 + cw, b = tok >> 11, s = tok & 2047;
        return vtc + ((size_t)(b * 33 + 1 + (s >> 6)) * 1024 + f) * 64 + (s & 63); } };
struct Job { const float* src; bf16_t* dst; int ldw, K, ndst, col0, mode, nvalid, tile0, pad; };
struct Params {
    const float *x, *meta, *ffn1_norm, *mix_norm, *ffn2_norm, *da_lambda, *da_subln, *gla_w_gate2, *gla_b_gate2, *gla_norm, *final_norm;
    float* out;
    bf16_t* w_ffn_in[4]; bf16_t* w_ffn_out[4];
    bf16_t *w_da_qk, *w_da_v, *w_da_out, *w_gla_main, *w_gla_v, *w_gla_out;
    bf16_t *big, *hn, *kdecT;
    bf16_t *qd, *kh, *vtc_da, *g2, *qh, *vtc_gla;
    float *hmeta, *glr, *decay;
    unsigned* bar; unsigned* xcnt; float* xbuf;
    Job jobs[16];
    int njobs, ntiles_prep, ph_lo, ph_hi;
};

__device__ __forceinline__ void prep_phase(const Params& p, unsigned char* shm) {
    float* tile = (float*)shm;
    const int tid = threadIdx.x;
    const int n4 = (tid & 31) * 4, kk0 = tid >> 5;
#define PREP_FETCH(T, V, DST, KK, K0, N0, VALID) do { \
        int j_ = 0; for (int q = 1; q < p.njobs; ++q) if ((T) >= p.jobs[q].tile0) j_ = q; \
        const Job jb = p.jobs[j_]; \
        const int lt = (T) - jb.tile0, nkt = jb.K / 128, kt = lt % nkt, ntile = lt / nkt; \
        K0 = kt * 128; N0 = ntile * 128; KK = jb.K; DST = jb.dst; \
        int scol; if (jb.mode == 1) { const int pn = N0 >> 8, bj = (N0 >> 7) & 1; scol = bj * DFF + 128 * pn; } else scol = jb.col0 + N0; \
        VALID = N0 < jb.nvalid; \
        if (VALID) { \
            _Pragma("unroll") for (int i = 0; i < 8; ++i) { \
                const float* s = jb.src + (size_t)(K0 + kk0 + 16 * i) * jb.ldw + scol + n4; \
                if (N0 + n4 + 3 < jb.nvalid) V[i] = __builtin_nontemporal_load((const f32x4*)s);     \
                else { for (int q = 0; q < 4; ++q) V[i][q] = (N0 + n4 + q < jb.nvalid) ? s[q] : 0.f; } } } } while (0)
    f32x4 v[8], vn[8];
    bf16_t* dstc = nullptr; bf16_t* dstn = nullptr; int Kc = 0, k0c = 0, n0c = 0, Kn = 0, k0n = 0, n0n = 0; bool validc = false, validn = false;
    int t = blockIdx.x;
    if (t < p.ntiles_prep) PREP_FETCH(t, v, dstc, Kc, k0c, n0c, validc);
    for (; t < p.ntiles_prep; t += gridDim.x) {
        const int tn = t + gridDim.x;
        if (tn < p.ntiles_prep) PREP_FETCH(tn, vn, dstn, Kn, k0n, n0n, validn);
        __syncthreads();
        if (validc) {
#pragma unroll
            for (int i = 0; i < 8; ++i) { float* tp = tile + (kk0 + 16 * i) * 129 + n4; tp[0] = v[i][0]; tp[1] = v[i][1]; tp[2] = v[i][2]; tp[3] = v[i][3]; }
        }
        __syncthreads();
        const int nn = (tid & 31) + 32 * ((tid >> 6) & 3), ks = ((tid >> 5) & 1) + 2 * (tid >> 8);
        bf16_t* dp = dstc + (size_t)(n0c + nn) * Kc + k0c + ks * 32;
#pragma unroll
        for (int q4 = 0; q4 < 4; ++q4) {
            u32x4 w = (u32x4){0u, 0u, 0u, 0u};
            if (validc) {
                float x[8];
#pragma unroll
                for (int q = 0; q < 8; ++q) x[q] = tile[(ks * 32 + q4 * 8 + q) * 129 + nn];
                w.x = cvt_pk_bf16(x[0], x[1]); w.y = cvt_pk_bf16(x[2], x[3]); w.z = cvt_pk_bf16(x[4], x[5]); w.w = cvt_pk_bf16(x[6], x[7]);
            }
            *(u32x4*)(dp + q4 * 8) = w;
        }
#pragma unroll
        for (int i = 0; i < 8; ++i) v[i] = vn[i];
        dstc = dstn; Kc = Kn; k0c = k0n; n0c = n0n; validc = validn;
    }
#undef PREP_FETCH
    for (int i = blockIdx.x * 512 + tid; i < XCNT_WORDS; i += gridDim.x * 512) p.xcnt[i] = 0u;
    for (int i = blockIdx.x * 512 + tid; i < MMETA * D / 4; i += gridDim.x * 512) {
        const int row = i / (D / 4), c4 = i % (D / 4);
        ((f32x4*)p.hmeta)[i] = ((const f32x4*)p.meta)[(row & 15) * (D / 4) + c4];
    }
}

__device__ __forceinline__ void norm_phase(const Params& p, const float* srcx, const float* gain, bool final_out, bool first = false) {
    const int wid = threadIdx.x >> 6, lane = threadIdx.x & 63;
    const int nrows = final_out ? MX : MTOT, stride = gridDim.x * 8;
    f32x4 g[4];
#pragma unroll
    for (int i = 0; i < 4; ++i) g[i] = *(const f32x4*)(gain + i * 256 + lane * 4);
    auto rowsrc = [&](int row) { return row < MX ? srcx + (size_t)row * D : (first ? p.meta + (size_t)((row - MX) & 15) * D : p.hmeta + (size_t)(row - MX) * D); };
    int row = blockIdx.x * 8 + wid;
    f32x4 v[4], vn[4];
    if (row < nrows) { const float* src = rowsrc(row);
#pragma unroll
        for (int i = 0; i < 4; ++i) v[i] = first ? __builtin_nontemporal_load((const f32x4*)(src + i * 256 + lane * 4)) : *(const f32x4*)(src + i * 256 + lane * 4); }
    for (; row < nrows; row += stride) {
        const int nrow = row + stride;
        if (nrow < nrows) { const float* src = rowsrc(nrow);
#pragma unroll
            for (int i = 0; i < 4; ++i) vn[i] = first ? __builtin_nontemporal_load((const f32x4*)(src + i * 256 + lane * 4)) : *(const f32x4*)(src + i * 256 + lane * 4); }
        float ss = 0.f;
#pragma unroll
        for (int i = 0; i < 4; ++i) ss += v[i][0] * v[i][0] + v[i][1] * v[i][1] + v[i][2] * v[i][2] + v[i][3] * v[i][3];
#pragma unroll
        for (int o = 32; o >= 1; o >>= 1) ss += __shfl_xor(ss, o);
        const float rstd = rsqrtf(ss * (1.0f / D) + RMS_EPS);
        if (final_out) {
            float* dst = p.out + (size_t)row * D;
#pragma unroll
            for (int i = 0; i < 4; ++i) *(f32x4*)(dst + i * 256 + lane * 4) = v[i] * rstd * g[i];
        } else {
            bf16_t* dst = p.hn + (size_t)row * D;
#pragma unroll
            for (int i = 0; i < 4; ++i) { const f32x4 y = v[i] * rstd * g[i]; u32x2 w; w.x = cvt_pk_bf16(y[0], y[1]); w.y = cvt_pk_bf16(y[2], y[3]); *(u32x2*)(dst + i * 256 + lane * 4) = w; }
        }
#pragma unroll
        for (int i = 0; i < 4; ++i) v[i] = vn[i];
    }
}

__device__ __forceinline__ void attn_phase(const Params& p, unsigned char* shm) {
    const int tid = threadIdx.x, wid = tid >> 6, lane = tid & 63, fr = lane & 15, fq = lane >> 4;
    const int qi = wid & 3, mp = wid >> 2;
    bf16_t* Ksb = (bf16_t*)shm;
    bf16_t* Vsb = (bf16_t*)(shm + 2 * 17408);
    float* Xs = (float*)shm;
    float lam;
    { float s0 = 0.f, s1 = 0.f; for (int d = 0; d < 64; ++d) { s0 += p.da_lambda[d] * p.da_lambda[64 + d]; s1 += p.da_lambda[128 + d] * p.da_lambda[192 + d]; }
      lam = __expf(s0) - __expf(s1) + 0.2f; }
    const float lam_init = 0.2f;
    const float sc2 = 0.125f * 1.44269504089f;
    const int kr0 = tid >> 4, kc0 = (tid & 15) * 8, vr0 = tid >> 3, vc0 = (tid & 7) * 8;
    const int kp0 = 16 * ((kr0 >> 2) & 1) + 4 * (kr0 >> 3) + (kr0 & 3);
    for (int v = blockIdx.x; v < 256; v += gridDim.x) {
        const int xcd = v & 7, slot = v >> 3, bh = xcd * 8 + (slot >> 2), jj = slot & 3, b = bh >> 3, h = bh & 7;
        const int nitems = (jj == 0) ? 5 : 4;
        const bf16_t* kbase = p.kh + ((size_t)(b * 8 + h) * NTOK + kr0) * 128 + kc0;
        const bf16_t* vbase = p.vtc_da + ((size_t)(b * 33) * 1024 + h * 128 + vr0) * 64 + vc0;
        for (int it = 0; it < nitems; ++it) {
            const bool meta = (it == 4);
            const int pp = meta ? 0 : ((it & 1) ? (8 * (it >> 1) + 7 - jj) : (8 * (it >> 1) + jj));
            const int ntiles = meta ? 1 : 2 * pp + 3;
            const int qrowA = (meta ? MX + b * 16 : b * SEQ + 128 * pp) + 16 * qi + fr;
            const int qrowB = meta ? qrowA : qrowA + 64;
            u32x4 kreg[2], vreg[2];
            { kreg[0] = *(const u32x4*)(kbase); kreg[1] = *(const u32x4*)(kbase + 32 * 128);
              vreg[0] = *(const u32x4*)(vbase); vreg[1] = *(const u32x4*)(vbase + 64 * 64); }
            bf16x8 Qf[2][2];
#pragma unroll
            for (int kd = 0; kd < 2; ++kd) { Qf[0][kd] = *(const bf16x8*)(p.qd + (size_t)qrowA * 1024 + h * 128 + mp * 64 + kd * 32 + fq * 8);
                                             Qf[1][kd] = *(const bf16x8*)(p.qd + (size_t)qrowB * 1024 + h * 128 + mp * 64 + kd * 32 + fq * 8); }
            f32x4 accO[2][8];
#pragma unroll
            for (int blk = 0; blk < 2; ++blk)
#pragma unroll
                for (int nb = 0; nb < 8; ++nb) accO[blk][nb] = (f32x4){0.f, 0.f, 0.f, 0.f};
            float mrun[2] = {-INFINITY, -INFINITY}, lrun[2] = {0.f, 0.f};
            __syncthreads();
            *(u32x4*)(Ksb + kp0 * 136 + kc0) = kreg[0]; *(u32x4*)(Ksb + (kp0 + 32) * 136 + kc0) = kreg[1];
            *(u32x4*)(Vsb + vr0 * 72 + vc0) = vreg[0]; *(u32x4*)(Vsb + (vr0 + 64) * 72 + vc0) = vreg[1];
            __syncthreads();
            for (int t = 0; t < ntiles; ++t) {
                const bf16_t* Ks = Ksb + (t & 1) * (64 * 136);
                const bf16_t* Vs = Vsb + (t & 1) * (128 * 72);
                if (t + 1 < ntiles) {
                    const bf16_t* kp = kbase + (size_t)(16 + 64 * t) * 128; const bf16_t* vp = vbase + (size_t)(t + 1) * 65536;
                    kreg[0] = *(const u32x4*)(kp); kreg[1] = *(const u32x4*)(kp + 32 * 128);
                    vreg[0] = *(const u32x4*)(vp); vreg[1] = *(const u32x4*)(vp + 64 * 64);
                }
                const bool actA = meta || (t + 1 < ntiles);
                f32x4 s[2][2][2];
                __builtin_amdgcn_s_setprio(1);
#pragma unroll
                for (int ks = 0; ks < 2; ++ks)
#pragma unroll
                    for (int a = 0; a < 2; ++a) {
                        f32x4 zA = (f32x4){0.f, 0.f, 0.f, 0.f}, zB = (f32x4){0.f, 0.f, 0.f, 0.f};
#pragma unroll
                        for (int kd = 0; kd < 2; ++kd) { const bf16x8 kf = *(const bf16x8*)(Ks + (32 * ks + 16 * a + fr) * 136 + mp * 64 + kd * 32 + fq * 8);
                            zA = __builtin_amdgcn_mfma_f32_16x16x32_bf16(kf, Qf[0][kd], zA, 0, 0, 0); zB = __builtin_amdgcn_mfma_f32_16x16x32_bf16(kf, Qf[1][kd], zB, 0, 0, 0); }
                        s[0][ks][a] = zA; s[1][ks][a] = zB;
                    }
                __builtin_amdgcn_s_setprio(0);
                if (t == 0) {
#pragma unroll
                    for (int blk = 0; blk < 2; ++blk)
#pragma unroll
                        for (int ks = 0; ks < 2; ++ks)
#pragma unroll
                            for (int a = 0; a < 2; ++a)
#pragma unroll
                                for (int j = 0; j < 4; ++j) if (32 * ks + 8 * fq + 4 * a + j >= 16) s[blk][ks][a][j] = -INFINITY;
                }
                bf16x8 Pf[2][2]; float alpha[2];
#pragma unroll
                for (int blk = 0; blk < 2; ++blk) {
                    float tm = -INFINITY;
#pragma unroll
                    for (int ks = 0; ks < 2; ++ks)
#pragma unroll
                        for (int a = 0; a < 2; ++a)
#pragma unroll
                            for (int j = 0; j < 4; ++j) tm = fmaxf(tm, s[blk][ks][a][j]);
                    tm = fmaxf(tm, __shfl_xor(tm, 16)); tm = fmaxf(tm, __shfl_xor(tm, 32));
                    const float mnew = fmaxf(mrun[blk], tm * sc2);
                    alpha[blk] = __builtin_amdgcn_exp2f(mrun[blk] - mnew);
                    float ps = 0.f;
#pragma unroll
                    for (int ks = 0; ks < 2; ++ks) {
                        float e[8];
#pragma unroll
                        for (int a = 0; a < 2; ++a)
#pragma unroll
                            for (int j = 0; j < 4; ++j) { e[4 * a + j] = __builtin_amdgcn_exp2f(__builtin_fmaf(s[blk][ks][a][j], sc2, -mnew)); ps += e[4 * a + j]; }
                        u32x4 w; w.x = cvt_pk_bf16(e[0], e[1]); w.y = cvt_pk_bf16(e[2], e[3]); w.z = cvt_pk_bf16(e[4], e[5]); w.w = cvt_pk_bf16(e[6], e[7]);
                        Pf[blk][ks] = __builtin_bit_cast(bf16x8, w);
                    }
                    if (blk == 1 || actA) { mrun[blk] = mnew; lrun[blk] = lrun[blk] * alpha[blk] + ps; }
                }
                __builtin_amdgcn_s_setprio(1);
                if (actA) {
#pragma unroll
                    for (int nb = 0; nb < 8; ++nb) {
                        f32x4 oA = accO[0][nb] * alpha[0], oB = accO[1][nb] * alpha[1];
#pragma unroll
                        for (int ks = 0; ks < 2; ++ks) { const bf16x8 vf = *(const bf16x8*)(Vs + (nb * 16 + fr) * 72 + ks * 32 + fq * 8);
                            oA = __builtin_amdgcn_mfma_f32_16x16x32_bf16(vf, Pf[0][ks], oA, 0, 0, 0); oB = __builtin_amdgcn_mfma_f32_16x16x32_bf16(vf, Pf[1][ks], oB, 0, 0, 0); }
                        accO[0][nb] = oA; accO[1][nb] = oB;
                    }
                } else {
#pragma unroll
                    for (int nb = 0; nb < 8; ++nb) {
                        f32x4 oB = accO[1][nb] * alpha[1];
#pragma unroll
                        for (int ks = 0; ks < 2; ++ks) { const bf16x8 vf = *(const bf16x8*)(Vs + (nb * 16 + fr) * 72 + ks * 32 + fq * 8); oB = __builtin_amdgcn_mfma_f32_16x16x32_bf16(vf, Pf[1][ks], oB, 0, 0, 0); }
                        accO[1][nb] = oB;
                    }
                }
                __builtin_amdgcn_s_setprio(0);
                if (t + 1 < ntiles) {
                    bf16_t* Kn = Ksb + ((t + 1) & 1) * (64 * 136); bf16_t* Vn = Vsb + ((t + 1) & 1) * (128 * 72);
                    *(u32x4*)(Kn + kp0 * 136 + kc0) = kreg[0]; *(u32x4*)(Kn + (kp0 + 32) * 136 + kc0) = kreg[1];
                    *(u32x4*)(Vn + vr0 * 72 + vc0) = vreg[0]; *(u32x4*)(Vn + (vr0 + 64) * 72 + vc0) = vreg[1];
                }
                __syncthreads();
            }
            float inv[2];
#pragma unroll
            for (int blk = 0; blk < 2; ++blk) { float l = lrun[blk]; l += __shfl_xor(l, 16); l += __shfl_xor(l, 32); inv[blk] = 1.0f / l; }
            if (mp == 1) {
#pragma unroll
                for (int blk = 0; blk < 2; ++blk)
#pragma unroll
                    for (int nb = 0; nb < 8; ++nb) *(f32x4*)(Xs + ((blk * 4 + qi) * 16 + fr) * 132 + nb * 16 + fq * 4) = accO[blk][nb] * inv[blk];
            }
            __syncthreads();
            if (mp == 0) {
#pragma unroll
                for (int blk = 0; blk < 2; ++blk) {
                    if (meta && (blk == 1 || qi != 0)) continue;
                    float ss = 0.f;
#pragma unroll
                    for (int nb = 0; nb < 8; ++nb) { const f32x4 o2 = *(const f32x4*)(Xs + ((blk * 4 + qi) * 16 + fr) * 132 + nb * 16 + fq * 4); const f32x4 o = accO[blk][nb] * inv[blk] - lam * o2; accO[blk][nb] = o; ss += o[0] * o[0] + o[1] * o[1] + o[2] * o[2] + o[3] * o[3]; }
                    ss += __shfl_xor(ss, 16); ss += __shfl_xor(ss, 32);
                    const float rs = rsqrtf(ss * (1.0f / 128.0f) + RMS_EPS) * (1.0f - lam_init);
                    bf16_t* dst = p.qd + (size_t)(blk ? qrowB : qrowA) * D + h * 128 + fq * 4;
#pragma unroll
                    for (int nb = 0; nb < 8; ++nb) { const f32x4 gg = *(const f32x4*)(p.da_subln + nb * 16 + fq * 4); const f32x4 y = accO[blk][nb] * rs * gg;
                        u32x2 w; w.x = cvt_pk_bf16(y[0], y[1]); w.y = cvt_pk_bf16(y[2], y[3]); *(u32x2*)(dst + nb * 16) = w; }
                }
            }
        }
    }
}

__device__ __forceinline__ void gla_prep_phase(const Params& p, unsigned char* shm) {
    float* gl = (float*)shm;
    bf16_t* kt = (bf16_t*)(shm + 4096);
    const int tid = threadIdx.x;
    float w2[16];
#pragma unroll
    for (int r = 0; r < 16; ++r) w2[r] = p.gla_w_gate2[r * 512 + tid];
    const float bias = p.gla_b_gate2[tid];
    for (int it = blockIdx.x; it < NB * 33; it += gridDim.x) {
        const int b = it < 256 ? (it >> 5) : (it - 256), ch = it < 256 ? 1 + (it & 31) : 0;
        const int item = b * 33 + ch;
        const int row0 = ch == 0 ? MX + b * 16 : b * SEQ + 64 * (ch - 1);
        const int nvalid = ch == 0 ? 16 : 64;
        __syncthreads();
        for (int i = tid; i < 1024; i += 512) gl[i] = p.glr[(size_t)row0 * 16 + i];
        { u32x4 kv[8];
#pragma unroll
          for (int i = 0; i < 8; ++i) { const int ch16 = tid + 512 * i, r = ch16 >> 6, c8 = (ch16 & 63) * 8; const int rr = r < nvalid ? r : nvalid - 1;
              kv[i] = *(const u32x4*)(p.g2 + (size_t)(row0 + rr) * 1536 + c8); }
#pragma unroll
          for (int i = 0; i < 8; ++i) { const int ch16 = tid + 512 * i, r = ch16 >> 6, c8 = (ch16 & 63) * 8; *(u32x4*)(kt + r * 512 + c8) = kv[i]; } }
        __syncthreads();
        float gend = 0.f;
        for (int t = 0; t < nvalid; ++t) {
            float z = bias;
#pragma unroll
            for (int r = 0; r < 16; ++r) z += gl[t * 16 + r] * w2[r];
            gend += (fminf(z, 0.f) - __logf(1.0f + __expf(-fabsf(z)))) * (1.0f / 16.0f);
        }
        p.decay[(size_t)item * 512 + tid] = __expf(gend);
        bf16_t* dst = p.kdecT + ((size_t)item * 512 + tid) * 64;
        float G = 0.f;
        for (int t8 = 0; t8 < 8; ++t8) {
            float kd[8];
#pragma unroll
            for (int q = 0; q < 8; ++q) {
                const int t = t8 * 8 + q;
                float val = 0.f;
                if (t < nvalid) {
                    float z = bias;
#pragma unroll
                    for (int r = 0; r < 16; ++r) z += gl[t * 16 + r] * w2[r];
                    G += (fminf(z, 0.f) - __logf(1.0f + __expf(-fabsf(z)))) * (1.0f / 16.0f);
                    val = bf2f(kt[t * 512 + tid]) * __expf(gend - G);
                }
                kd[q] = val;
            }
            u32x4 w; w.x = cvt_pk_bf16(kd[0], kd[1]); w.y = cvt_pk_bf16(kd[2], kd[3]); w.z = cvt_pk_bf16(kd[4], kd[5]); w.w = cvt_pk_bf16(kd[6], kd[7]);
            *(u32x4*)(dst + t8 * 8) = w;
        }
    }
}

struct ScanOps { bf16x8 Af[2], Bf[2][2], Qf[4]; f32x4 dc; };
__device__ __forceinline__ void scan_load(ScanOps& o, const Params& p, int b, int h, int dvs, int ch, int wid, int fr, int fq) {
    const int item = b * 33 + ch;
    const int tok0 = ch == 0 ? 0 : 16 + 64 * (ch - 1);
    const int tb = wid >> 1;
#pragma unroll
    for (int ks = 0; ks < 2; ++ks) {
        o.Af[ks] = *(const bf16x8*)(p.kdecT + ((size_t)item * 512 + h * 128 + wid * 16 + fr) * 64 + ks * 32 + fq * 8);
#pragma unroll
        for (int vb = 0; vb < 2; ++vb) o.Bf[vb][ks] = *(const bf16x8*)(p.vtc_gla + ((size_t)item * 1024 + h * 256 + dvs * 32 + vb * 16 + fr) * 64 + ks * 32 + fq * 8);
    }
    o.dc = *(const f32x4*)(p.decay + (size_t)item * 512 + h * 128 + wid * 16 + fq * 4);
#pragma unroll
    for (int kc = 0; kc < 4; ++kc) o.Qf[kc] = *(const bf16x8*)(p.qh + ((size_t)(b * 4 + h) * NTOK + tok0 + tb * 16 + fr) * 128 + kc * 32 + fq * 8);
}
__device__ __forceinline__ void gla_scan_phase(const Params& p, unsigned char* shm) {
    const int tid = threadIdx.x, wid = tid >> 6, lane = tid & 63, fr = lane & 15, fq = lane >> 4;
    bf16_t* Ssb = (bf16_t*)shm;
    const float qscale = 0.08838834764831845f;
    for (int wg = blockIdx.x; wg < 256; wg += gridDim.x) {
        const int xcd_ = wg & 7, slot_ = wg >> 3, bh_ = xcd_ * 4 + (slot_ >> 3);
        const int b = bh_ >> 2, h = bh_ & 3, dvs = slot_ & 7;
        f32x4 accS[2] = {(f32x4){0.f, 0.f, 0.f, 0.f}, (f32x4){0.f, 0.f, 0.f, 0.f}};
        const int tb = wid >> 1, vb2 = wid & 1;
        ScanOps r0, r1, r2, r3;
        scan_load(r0, p, b, h, dvs, 0, wid, fr, fq);
        scan_load(r1, p, b, h, dvs, 1, wid, fr, fq);
        scan_load(r2, p, b, h, dvs, 2, wid, fr, fq);
        __syncthreads();
#define SCAN_STEP(CUR, NXT, CH) do { const int ch_ = (CH); \
            const int row0 = ch_ == 0 ? MX + b * 16 : b * SEQ + 64 * (ch_ - 1); const int nvalid = ch_ == 0 ? 16 : 64; \
            bf16_t* Ss = Ssb + (ch_ & 1) * (32 * 136); \
            if (ch_ + 3 < 33) scan_load(NXT, p, b, h, dvs, ch_ + 3, wid, fr, fq); \
            _Pragma("unroll") for (int vb = 0; vb < 2; ++vb) { \
                f32x4 s = accS[vb] * CUR.dc; \
                _Pragma("unroll") for (int ks = 0; ks < 2; ++ks) s = __builtin_amdgcn_mfma_f32_16x16x32_bf16(CUR.Af[ks], CUR.Bf[vb][ks], s, 0, 0, 0); \
                accS[vb] = s; \
                u32x2 w; w.x = cvt_pk_bf16(s[0], s[1]); w.y = cvt_pk_bf16(s[2], s[3]); \
                *(u32x2*)(Ss + (vb * 16 + fr) * 136 + wid * 16 + fq * 4) = w; } \
            asm volatile("s_waitcnt lgkmcnt(0)" ::: "memory"); __builtin_amdgcn_s_barrier(); asm volatile("" ::: "memory");     \
            f32x4 o = (f32x4){0.f, 0.f, 0.f, 0.f}; \
            _Pragma("unroll") for (int kc = 0; kc < 4; ++kc) { const bf16x8 sf = *(const bf16x8*)(Ss + (vb2 * 16 + fr) * 136 + kc * 32 + fq * 8); o = __builtin_amdgcn_mfma_f32_16x16x32_bf16(sf, CUR.Qf[kc], o, 0, 0, 0); } \
            if (tb * 16 + fr < nvalid) { o = o * qscale; u32x2 w; w.x = cvt_pk_bf16(o[0], o[1]); w.y = cvt_pk_bf16(o[2], o[3]); \
                *(u32x2*)(p.hn + (size_t)(row0 + tb * 16 + fr) * D + h * 256 + dvs * 32 + vb2 * 16 + fq * 4) = w; } \
        } while (0)
        for (int c4 = 0; c4 < 32; c4 += 4) {
            SCAN_STEP(r0, r3, c4); SCAN_STEP(r1, r0, c4 + 1); SCAN_STEP(r2, r1, c4 + 2); SCAN_STEP(r3, r2, c4 + 3);
        }
        SCAN_STEP(r0, r3, 32);
#undef SCAN_STEP
        __syncthreads();
    }
}

__device__ __forceinline__ void gla_post_phase(const Params& p) {
    const int wid = threadIdx.x >> 6, lane = threadIdx.x & 63, stride = gridDim.x * 8;
    const f32x4 g = *(const f32x4*)(p.gla_norm + lane * 4);
    int row = blockIdx.x * 8 + wid;
    u32x2 ow[4], gw[4], own[4], gwn[4];
    if (row < MTOT) {
#pragma unroll
        for (int h = 0; h < 4; ++h) { ow[h] = *(const u32x2*)(p.hn + (size_t)row * D + h * 256 + lane * 4); gw[h] = *(const u32x2*)(p.g2 + (size_t)row * 1536 + 512 + h * 256 + lane * 4); } }
    for (; row < MTOT; row += stride) {
        const int nrow = row + stride;
        if (nrow < MTOT) {
#pragma unroll
            for (int h = 0; h < 4; ++h) { own[h] = *(const u32x2*)(p.hn + (size_t)nrow * D + h * 256 + lane * 4); gwn[h] = *(const u32x2*)(p.g2 + (size_t)nrow * 1536 + 512 + h * 256 + lane * 4); } }
#pragma unroll
        for (int h = 0; h < 4; ++h) {
            const float o0 = bflo(ow[h].x), o1 = bfhi(ow[h].x), o2 = bflo(ow[h].y), o3 = bfhi(ow[h].y);
            float ss = o0 * o0 + o1 * o1 + o2 * o2 + o3 * o3;
#pragma unroll
            for (int o = 32; o >= 1; o >>= 1) ss += __shfl_xor(ss, o);
            const float rs = rsqrtf(ss * (1.0f / 256.0f) + RMS_EPS);
            const float y0 = o0 * rs * g[0] * silu_f(bflo(gw[h].x)), y1 = o1 * rs * g[1] * silu_f(bfhi(gw[h].x)), y2 = o2 * rs * g[2] * silu_f(bflo(gw[h].y)), y3 = o3 * rs * g[3] * silu_f(bfhi(gw[h].y));
            u32x2 w; w.x = cvt_pk_bf16(y0, y1); w.y = cvt_pk_bf16(y2, y3);
            *(u32x2*)(p.g2 + (size_t)row * 1536 + 512 + h * 256 + lane * 4) = w;
        }
#pragma unroll
        for (int h = 0; h < 4; ++h) { ow[h] = own[h]; gw[h] = gwn[h]; }
    }
}

template <int NBLK, bool TRANS_OUT, class Fin>
__device__ __forceinline__ void small_gemm_item(unsigned char* shm, const bf16_t* A, int lda, const bf16_t* Bt0, const bf16_t* Bt1, int K, const Fin& fin) {
    const int tid = threadIdx.x, wid = tid >> 6, lane = tid & 63, fr = lane & 15, fq = lane >> 4;
    const int kw = K >> 3, k0 = wid * kw;
    f32x4 acc[8][NBLK];
#pragma unroll
    for (int rb = 0; rb < 8; ++rb)
#pragma unroll
        for (int cb = 0; cb < NBLK; ++cb) acc[rb][cb] = (f32x4){0.f, 0.f, 0.f, 0.f};
    const bf16_t* ap = A + (size_t)fr * lda + k0 + fq * 8;
    const bf16_t* bp0 = Bt0 + (size_t)fr * K + k0 + fq * 8;
    const bf16_t* bp1 = Bt1 + (size_t)fr * K + k0 + fq * 8;
    bf16x8 bf[NBLK], af[8], bfn[NBLK], afn[8];
    bf[0] = *(const bf16x8*)(bp0);
    if (NBLK > 1) bf[NBLK - 1] = *(const bf16x8*)(bp1);
#pragma unroll
    for (int rb = 0; rb < 8; ++rb) af[rb] = *(const bf16x8*)(ap + (size_t)rb * 16 * lda);
#pragma unroll 1
    for (int k = 0; k < kw; k += 32) {
        const int kn = (k + 32 < kw) ? k + 32 : k;
        bfn[0] = *(const bf16x8*)(bp0 + kn);
        if (NBLK > 1) bfn[NBLK - 1] = *(const bf16x8*)(bp1 + kn);
#pragma unroll
        for (int rb = 0; rb < 8; ++rb) afn[rb] = *(const bf16x8*)(ap + (size_t)rb * 16 * lda + kn);
#pragma unroll
        for (int rb = 0; rb < 8; ++rb)
#pragma unroll
            for (int cb = 0; cb < NBLK; ++cb)
                acc[rb][cb] = TRANS_OUT ? __builtin_amdgcn_mfma_f32_16x16x32_bf16(af[rb], bf[cb], acc[rb][cb], 0, 0, 0)
                                        : __builtin_amdgcn_mfma_f32_16x16x32_bf16(bf[cb], af[rb], acc[rb][cb], 0, 0, 0);
#pragma unroll
        for (int cb = 0; cb < NBLK; ++cb) bf[cb] = bfn[cb];
#pragma unroll
        for (int rb = 0; rb < 8; ++rb) af[rb] = afn[rb];
    }
    f32x4* part = (f32x4*)shm;
    __syncthreads();
#pragma unroll
    for (int rb = 0; rb < 8; ++rb)
#pragma unroll
        for (int cb = 0; cb < NBLK; ++cb) part[((wid * 8 + rb) * NBLK + cb) * 64 + lane] = acc[rb][cb];
    __syncthreads();
    f32x4 sum[NBLK];
#pragma unroll
    for (int cb = 0; cb < NBLK; ++cb) {
        f32x4 s = (f32x4){0.f, 0.f, 0.f, 0.f};
#pragma unroll
        for (int w = 0; w < 8; ++w) s += part[((w * 8 + wid) * NBLK + cb) * 64 + lane];
        sum[cb] = s;
    }
    fin(wid, sum, fr, fq);
    __syncthreads();
}
__device__ __forceinline__ u32x2 pack4(const f32x4 v) { u32x2 w; w.x = cvt_pk_bf16(v[0], v[1]); w.y = cvt_pk_bf16(v[2], v[3]); return w; }

#define SMALL_ITEMS(i, n) for (int i = (int)gridDim.x - 1 - (int)blockIdx.x; i < (n); i += (int)gridDim.x)

__device__ __forceinline__ void ph_ffn_in(const Params& p, unsigned char* shm, int widx) {
    const bf16_t* W = p.w_ffn_in[widx];
    SMALL_ITEMS(i, DFF / 16) {
        const int pn = (16 * i) >> 7, within = (16 * i) & 127;
        bf16_t* O = p.big;
        auto fin = [=](int rb, const f32x4 (&s)[2], int fr, int fq) {
            f32x4 y; for (int j = 0; j < 4; ++j) y[j] = silu_f(s[0][j]) * s[1][j];
            *(u32x2*)(O + (size_t)(MX + rb * 16 + fr) * DFF + 16 * i + fq * 4) = pack4(y); };
        small_gemm_item<2, false>(shm, p.hn + (size_t)MX * D, D, W + (size_t)(256 * pn + within) * D, W + (size_t)(256 * pn + 128 + within) * D, D, fin);
    }
    pg8::StaticOrder S; pg8::Gemm g{p.hn, W, MX, 2 * DFF, D, D}; S.init(g.M, g.N, gridDim.x, blockIdx.x);
    EpiSwiGLU E{p.big};
    if (S.split_tail()) {
        S.mode = 1; pg8::gemm_phase((LAS unsigned char*)shm, g, S, E);
        S.mode = 2;
        if (blockIdx.x & 1) pg8::gemm_phase<EpiSwiGLU, 2>((LAS unsigned char*)shm, g, S, E);
        else pg8::gemm_phase<EpiSwiGLU, 1>((LAS unsigned char*)shm, g, S, E);
    } else pg8::gemm_phase((LAS unsigned char*)shm, g, S, E);
}
template <bool HALFS, bool FINAL, bool BASEF32>
__device__ __forceinline__ void ph_resid(const Params& p, unsigned char* shm, const bf16_t* A, int lda, const bf16_t* Bt, int K, const float* base_x, const float* gain, int inst) {
    constexpr float scale = HALFS ? 0.5f : 1.0f;
    if (!FINAL) {
        unsigned* cmeta = p.xcnt + 6 * 64 * 64 + inst * 64;
        SMALL_ITEMS(i, D / 32) {
            float* H = p.hmeta;
            auto fin = [=](int rb, const f32x4 (&s)[2], int fr, int fq) {
#pragma unroll
                for (int cb = 0; cb < 2; ++cb) { float* hp = H + (size_t)(rb * 16 + fr) * D + 32 * i + cb * 16 + fq * 4; *(f32x4*)hp = *(const f32x4*)hp + scale * s[cb]; } };
            small_gemm_item<2, false>(shm, A + (size_t)MX * lda, lda, Bt + (size_t)(32 * i) * K, Bt + (size_t)(32 * i + 16) * K, K, fin);
            asm volatile("s_waitcnt vmcnt(0)" ::: "memory");
            __syncthreads();
            LAS unsigned* flag = (LAS unsigned*)shm;
            if (threadIdx.x == 0) {
                __builtin_amdgcn_fence(__ATOMIC_RELEASE, "agent");
                asm volatile("s_waitcnt vmcnt(0)" ::: "memory");
                const unsigned old = __hip_atomic_fetch_add(cmeta, 1u, __ATOMIC_RELAXED, __HIP_MEMORY_SCOPE_AGENT);
                const unsigned last = (old == (unsigned)(D / 32 - 1)) ? 1u : 0u;
                if (last) { __builtin_amdgcn_fence(__ATOMIC_ACQUIRE, "agent"); asm volatile("s_waitcnt vmcnt(0)" ::: "memory"); }
                *flag = last;
            }
            __syncthreads();
            if (*flag) {
                const int wid = threadIdx.x >> 6, lane = threadIdx.x & 63;
                f32x4 g[4];
#pragma unroll
                for (int q = 0; q < 4; ++q) g[q] = *(const f32x4*)(gain + q * 256 + lane * 4);
                f32x4 v[4], vn[4];
                { const float* s = p.hmeta + (size_t)(wid * 16) * D;
#pragma unroll
                  for (int q = 0; q < 4; ++q) v[q] = *(const f32x4*)(s + q * 256 + lane * 4); }
                for (int rr = 0; rr < 16; ++rr) {
                    const int row = wid * 16 + rr;
                    { const float* s = p.hmeta + (size_t)(rr < 15 ? row + 1 : row) * D;
#pragma unroll
                      for (int q = 0; q < 4; ++q) vn[q] = *(const f32x4*)(s + q * 256 + lane * 4); }
                    float ss = 0.f;
#pragma unroll
                    for (int q = 0; q < 4; ++q) ss += v[q][0] * v[q][0] + v[q][1] * v[q][1] + v[q][2] * v[q][2] + v[q][3] * v[q][3];
#pragma unroll
                    for (int o = 32; o >= 1; o >>= 1) ss += __shfl_xor(ss, o);
                    const float rstd = rsqrtf(ss * (1.0f / D) + RMS_EPS);
                    bf16_t* dst = p.hn + (size_t)(MX + row) * D;
#pragma unroll
                    for (int q = 0; q < 4; ++q) { const f32x4 y = v[q] * rstd * g[q]; u32x2 w; w.x = cvt_pk_bf16(y[0], y[1]); w.y = cvt_pk_bf16(y[2], y[3]); *(u32x2*)(dst + q * 256 + lane * 4) = w; }
#pragma unroll
                    for (int q = 0; q < 4; ++q) v[q] = vn[q];
                }
            }
            __syncthreads();
        }
    }
    pg8::StaticOrder S; pg8::Gemm g{A, Bt, MX, D, K, lda}; S.init(g.M, g.N, gridDim.x, blockIdx.x);
    EpiResidNorm<HALFS, FINAL, BASEF32> E{base_x, p.out, p.hn, gain, p.xbuf + (size_t)inst * 64 * 256 * 4, p.xcnt + inst * 64 * 64};
    pg8::gemm_phase((LAS unsigned char*)shm, g, S, E);
}
__device__ __forceinline__ void ph_da_qk(const Params& p, unsigned char* shm) {
    const bf16_t* Bt = p.w_da_qk; const DstDaQK dst{p.qd, p.kh};
    SMALL_ITEMS(i, 2048 / 32) {
        auto fin = [=](int rb, const f32x4 (&s)[2], int fr, int fq) {
#pragma unroll
            for (int cb = 0; cb < 2; ++cb) { const int c = 32 * i + cb * 16 + fq * 4;
                bf16_t* d = c < 1024 ? dst.Qd + (size_t)(MX + rb * 16 + fr) * 1024 + c : dst.Kh + ((size_t)(rb * 8 + ((c - 1024) >> 7)) * NTOK + fr) * 128 + (c & 127);
                *(u32x2*)d = pack4(s[cb]); } };
        small_gemm_item<2, false>(shm, p.hn + (size_t)MX * D, D, Bt + (size_t)(32 * i) * D, Bt + (size_t)(32 * i + 16) * D, D, fin);
    }
    pg8::StaticOrder S; pg8::Gemm g{p.hn, Bt, MX, 2048, D, D}; S.init(g.M, g.N, gridDim.x, blockIdx.x);
    EpiBf16T<DstDaQK> E{dst}; pg8::gemm_phase((LAS unsigned char*)shm, g, S, E);
}
__device__ __forceinline__ void ph_gla_main(const Params& p, unsigned char* shm) {
    const bf16_t* Bt = p.w_gla_main; const DstGlaMain dst{p.qh, p.g2};
    SMALL_ITEMS(i, 2048 / 32) {
        auto fin = [=](int rb, const f32x4 (&s)[2], int fr, int fq) {
#pragma unroll
            for (int cb = 0; cb < 2; ++cb) { const int c = 32 * i + cb * 16 + fq * 4;
                bf16_t* d = c < 512 ? dst.qh + ((size_t)(rb * 4 + (c >> 7)) * NTOK + fr) * 128 + (c & 127) : dst.g2 + (size_t)(MX + rb * 16 + fr) * 1536 + (c - 512);
                *(u32x2*)d = pack4(s[cb]); } };
        small_gemm_item<2, false>(shm, p.hn + (size_t)MX * D, D, Bt + (size_t)(32 * i) * D, Bt + (size_t)(32 * i + 16) * D, D, fin);
    }
    pg8::StaticOrder S; pg8::Gemm g{p.hn, Bt, MX, 2048, D, D}; S.init(g.M, g.N, gridDim.x, blockIdx.x);
    EpiBf16T<DstGlaMain> E{dst}; pg8::gemm_phase((LAS unsigned char*)shm, g, S, E);
}
__device__ __forceinline__ void ph_vt(unsigned char* shm, const bf16_t* Wv, const bf16_t* hn, bf16_t* vtc) {
    SMALL_ITEMS(i, 1024 / 32) {
        auto fin = [=](int rb, const f32x4 (&s)[2], int fr, int fq) {
#pragma unroll
            for (int cb = 0; cb < 2; ++cb) *(u32x2*)(vtc + ((size_t)(rb * 33) * 1024 + 32 * i + cb * 16 + fr) * 64 + fq * 4) = pack4(s[cb]); };
        small_gemm_item<2, true>(shm, hn + (size_t)MX * D, D, Wv + (size_t)(32 * i) * D, Wv + (size_t)(32 * i + 16) * D, D, fin);
    }
    pg8::StaticOrder S; pg8::Gemm g{Wv, hn, 1024, MX, D, D}; S.init(g.M, g.N, gridDim.x, blockIdx.x);
    EpiBf16T<DstVTc> E{DstVTc{vtc}}; pg8::gemm_phase((LAS unsigned char*)shm, g, S, E);
}
__device__ __forceinline__ void ph_glr(const Params& p, unsigned char* shm) {
    SMALL_ITEMS(i, MTOT / 128) {
        float* G = p.glr;
        auto fin = [=](int rb, const f32x4 (&s)[1], int fr, int fq) { *(f32x4*)(G + (size_t)(128 * i + rb * 16 + fr) * 16 + fq * 4) = s[0]; };
        const bf16_t* Wg = p.w_gla_main + (size_t)2048 * D;
        small_gemm_item<1, false>(shm, p.hn + (size_t)(128 * i) * D, D, Wg, Wg, D, fin);
    }
}

constexpr int NPHASES = 24;
#define XB_TMO      128
#define XB_XCNT(j)  (256  + 64 * (j))
#define XB_XSUB(j)  (1280 + 64 * (j))
#define XB_XGEN(j)  (2304 + 64 * (j))
#define XB_TOP      3328
#define XB_TOPGEN   3392
#define XCD_BAR_WORDS 3456
#define XB_SPIN_CAP (1u << 18)
__device__ __forceinline__ unsigned xb_ld(unsigned* p)              { return __hip_atomic_load(p, __ATOMIC_RELAXED, __HIP_MEMORY_SCOPE_AGENT); }
__device__ __forceinline__ unsigned xb_add(unsigned* p, unsigned v) { return __hip_atomic_fetch_add(p, v, __ATOMIC_RELAXED, __HIP_MEMORY_SCOPE_AGENT); }
__device__ __forceinline__ unsigned xb_xcc_id() { return (unsigned)__builtin_amdgcn_s_getreg((3 << 11) | 20) & 0xFu; }
#define XB_SPIN(cond, bar) do { unsigned _sp = 0; while (cond) { __builtin_amdgcn_s_sleep(1); \
    if ((++_sp & 255u) == 0u) { if (xb_ld(&(bar)[XB_TMO])) break; if (_sp > XB_SPIN_CAP) { atomicAdd(&(bar)[XB_TMO], 1u); break; } } } } while (0)
struct XcdBarrier { unsigned* bar; unsigned x; volatile LAS unsigned* st; };
__device__ __forceinline__ XcdBarrier xcd_barrier_post(unsigned* bar, volatile LAS unsigned* st) {
    XcdBarrier b; b.bar = bar; b.x = xb_xcc_id(); b.st = st;
    if (threadIdx.x == 0) (void)xb_add(&bar[XB_XCNT(b.x)], 1u);
    return b;
}
__device__ __forceinline__ void xcd_barrier_complete(unsigned* bar, unsigned x, unsigned& nloc, unsigned& nx) {
    const unsigned G = gridDim.x * gridDim.y * gridDim.z;
    unsigned sum, cnt, mine, sp = 0u;
    for (;;) {
        sum = 0u; cnt = 0u; mine = 0u;
#pragma unroll
        for (unsigned j = 0; j < 16; ++j) { const unsigned c = xb_ld(&bar[XB_XCNT(j)]); sum += c; cnt += (c > 0u) ? 1u : 0u; mine = (j == x) ? c : mine; }
        if (sum == G) break;
        __builtin_amdgcn_s_sleep(1);
        if ((++sp & 255u) == 0u) { if (xb_ld(&bar[XB_TMO])) break; if (sp > XB_SPIN_CAP) { atomicAdd(&bar[XB_TMO], 1u); break; } }
    }
    nloc = mine > 0u ? mine : 1u; nx = cnt > 0u ? cnt : 1u;
}
__device__ __attribute__((noinline)) void xcd_barrier(unsigned* barp) {
    extern __shared__ __attribute__((aligned(16))) unsigned char shm_xb[];
    XcdBarrier b; b.bar = barp; b.x = xb_xcc_id(); b.st = (volatile LAS unsigned*)((LAS unsigned char*)shm_xb + LDS_BYTES);
    asm volatile("s_waitcnt vmcnt(0)" ::: "memory");
    __syncthreads();
    if (threadIdx.x == 0) {
        unsigned* bar = b.bar;
        __builtin_amdgcn_s_waitcnt(0);
        unsigned nloc = b.st[0], nx = b.st[1];
        if (nloc == 0u) { xcd_barrier_complete(bar, b.x, nloc, nx); b.st[0] = nloc; b.st[1] = nx; }
        const unsigned old = xb_add(&bar[XB_XSUB(b.x)], 1u);
        const unsigned gen = old / nloc;
        if (old + 1u == (gen + 1u) * nloc) {
            __builtin_amdgcn_fence(__ATOMIC_RELEASE, "agent");
            asm volatile("s_waitcnt vmcnt(0)" ::: "memory");
            const unsigned og = xb_add(&bar[XB_TOP], 1u);
            const unsigned tg = og / nx;
            if (og + 1u == (tg + 1u) * nx) xb_add(&bar[XB_TOPGEN], 1u);
            else XB_SPIN(xb_ld(&bar[XB_TOPGEN]) == tg, bar);
            __builtin_amdgcn_fence(__ATOMIC_ACQUIRE, "agent");
            xb_add(&bar[XB_XGEN(b.x)], 1u);
            asm volatile("s_waitcnt vmcnt(0)" ::: "memory");
        } else {
            XB_SPIN(xb_ld(&bar[XB_XGEN(b.x)]) == gen, bar);
            __builtin_amdgcn_fence(__ATOMIC_ACQUIRE, "agent");
            asm volatile("s_waitcnt vmcnt(0)" ::: "memory");
        }
    }
    __syncthreads();
}
#ifndef PROBE_MASK
#define PROBE_MASK 0u
#endif
#define RUN(idx, ...) if (p.ph_lo <= (idx) && (idx) < p.ph_hi) { if ((PROBE_MASK >> (idx)) & 1u) { __VA_ARGS__; xcd_barrier(p.bar); } __VA_ARGS__; if ((idx) < 22 && (idx) + 1 < p.ph_hi) xcd_barrier(p.bar); }

__global__ void __launch_bounds__(512, 2) fwd_megakernel(const Params p) {
    extern __shared__ __attribute__((aligned(16))) unsigned char shm[];
    cg::grid_group grid = cg::this_grid();
    if (p.ph_hi > 1000) grid.sync();
    volatile LAS unsigned* xst = (volatile LAS unsigned*)((LAS unsigned char*)shm + LDS_BYTES);
    if (threadIdx.x == 0) { xst[0] = 0u; xst[1] = 0u; }
    __syncthreads();
    (void)xcd_barrier_post(p.bar, xst);
    RUN(0, prep_phase(p, shm); norm_phase(p, p.x, p.ffn1_norm, false, true))
    RUN(2, ph_ffn_in(p, shm, 0))
    RUN(3, (ph_resid<true, false, true>(p, shm, p.big, DFF, p.w_ffn_out[0], DFF, p.x, p.mix_norm, 0)))
    RUN(5, ph_da_qk(p, shm); ph_vt(shm, p.w_da_v, p.hn, p.vtc_da))
    RUN(6, attn_phase(p, shm))
    RUN(7, (ph_resid<false, false, false>(p, shm, p.qd, D, p.w_da_out, D, p.out, p.ffn2_norm, 1)))
    RUN(9, ph_ffn_in(p, shm, 1))
    RUN(10, (ph_resid<true, false, false>(p, shm, p.big, DFF, p.w_ffn_out[1], DFF, p.out, p.ffn1_norm + D, 2)))
    RUN(12, ph_ffn_in(p, shm, 2))
    RUN(13, (ph_resid<true, false, false>(p, shm, p.big, DFF, p.w_ffn_out[2], DFF, p.out, p.mix_norm + D, 3)))
    RUN(15, ph_glr(p, shm); ph_gla_main(p, shm); ph_vt(shm, p.w_gla_v, p.hn, p.vtc_gla))
    RUN(16, gla_prep_phase(p, shm))
    RUN(17, gla_scan_phase(p, shm))
    RUN(18, gla_post_phase(p))
    RUN(19, (ph_resid<false, false, false>(p, shm, p.g2 + 512, 1536, p.w_gla_out, D, p.out, p.ffn2_norm + D, 4)))
    RUN(21, ph_ffn_in(p, shm, 3))
    RUN(22, (ph_resid<true, true, false>(p, shm, p.big, DFF, p.w_ffn_out[3], DFF, p.out, p.final_norm, 5)))
}

#ifndef N_LAUNCH_MODE
#define N_LAUNCH_MODE 0
#endif

extern "C" void kernel_launch(void* const* d_in, const int* in_sizes, int n_in, void* d_out, int out_size, void* d_ws, size_t ws_size, hipStream_t stream) {
    (void)in_sizes; (void)n_in; (void)out_size;
    Params p; memset(&p, 0, sizeof(p));
    const float* x = (const float*)d_in[0];
    p.x = x; p.meta = (const float*)d_in[1]; p.ffn1_norm = (const float*)d_in[2];
    const float* ffn1_w_in = (const float*)d_in[3]; const float* ffn1_w_out = (const float*)d_in[4];
    p.mix_norm = (const float*)d_in[5]; p.ffn2_norm = (const float*)d_in[6];
    const float* ffn2_w_in = (const float*)d_in[7]; const float* ffn2_w_out = (const float*)d_in[8];
    const float* da_w_in = (const float*)d_in[9]; p.da_lambda = (const float*)d_in[10]; p.da_subln = (const float*)d_in[11];
    const float* da_w_out = (const float*)d_in[12]; const float* gla_w_in = (const float*)d_in[13];
    p.gla_w_gate2 = (const float*)d_in[14]; p.gla_b_gate2 = (const float*)d_in[15]; p.gla_norm = (const float*)d_in[16];
    const float* gla_w_out = (const float*)d_in[17]; p.final_norm = (const float*)d_in[18];
    p.out = (float*)d_out;

    char* ws = (char*)d_ws; size_t off = 0;
    auto take = [&](size_t bytes) { char* r = ws + off; off += (bytes + 255) & ~(size_t)255; return r; };
    for (int i = 0; i < 4; ++i) p.w_ffn_in[i] = (bf16_t*)take((size_t)2 * DFF * D * 2);
    for (int i = 0; i < 4; ++i) p.w_ffn_out[i] = (bf16_t*)take((size_t)D * DFF * 2);
    p.w_da_qk = (bf16_t*)take((size_t)2048 * D * 2); p.w_da_v = (bf16_t*)take((size_t)1024 * D * 2); p.w_da_out = (bf16_t*)take((size_t)1024 * D * 2);
    p.w_gla_main = (bf16_t*)take((size_t)2304 * D * 2); p.w_gla_v = (bf16_t*)take((size_t)1024 * D * 2); p.w_gla_out = (bf16_t*)take((size_t)1024 * D * 2);
    p.big = (bf16_t*)take((size_t)51314688 * 2);
    p.qd = p.big; p.kh = p.big + (size_t)MP * 1024; p.vtc_da = p.kh + (size_t)64 * NTOK * 128;
    p.g2 = p.big; p.qh = p.big + (size_t)MP * 1536; p.vtc_gla = p.qh + (size_t)32 * NTOK * 128;
    p.hn = (bf16_t*)take((size_t)MP * D * 2);
    p.kdecT = (bf16_t*)take((size_t)NB * 33 * 512 * 64 * 2);
    p.hmeta = (float*)take((size_t)256 * D * 4);
    p.glr = (float*)take((size_t)MP * 16 * 4);
    p.decay = (float*)take((size_t)NB * 33 * 512 * 4);
    p.bar = (unsigned*)take((size_t)(XCD_BAR_WORDS + XCNT_WORDS) * 4); p.xcnt = p.bar + XCD_BAR_WORDS;
    p.xbuf = (float*)take((size_t)6 * 64 * 256 * 4 * 4);
    if (off > ws_size) { fprintf(stderr, "workspace too small: need %zu have %zu\n", off, ws_size); return; }

    int nj = 0, tiles = 0;
    auto add = [&](const float* src, bf16_t* dst, int ldw, int K, int ndst, int col0, int mode, int nvalid) {
        Job& j = p.jobs[nj++]; j.src = src; j.dst = dst; j.ldw = ldw; j.K = K; j.ndst = ndst; j.col0 = col0; j.mode = mode; j.nvalid = nvalid; j.tile0 = tiles; j.pad = 0;
        tiles += (K / 128) * (ndst / 128); };
    add(ffn1_w_in, p.w_ffn_in[0], 2 * DFF, D, 2 * DFF, 0, 1, 2 * DFF);
    add(ffn2_w_in, p.w_ffn_in[1], 2 * DFF, D, 2 * DFF, 0, 1, 2 * DFF);
    add(ffn1_w_in + (size_t)D * 2 * DFF, p.w_ffn_in[2], 2 * DFF, D, 2 * DFF, 0, 1, 2 * DFF);
    add(ffn2_w_in + (size_t)D * 2 * DFF, p.w_ffn_in[3], 2 * DFF, D, 2 * DFF, 0, 1, 2 * DFF);
    add(ffn1_w_out, p.w_ffn_out[0], D, DFF, D, 0, 0, D);
    add(ffn2_w_out, p.w_ffn_out[1], D, DFF, D, 0, 0, D);
    add(ffn1_w_out + (size_t)DFF * D, p.w_ffn_out[2], D, DFF, D, 0, 0, D);
    add(ffn2_w_out + (size_t)DFF * D, p.w_ffn_out[3], D, DFF, D, 0, 0, D);
    add(da_w_in, p.w_da_qk, 3072, D, 2048, 0, 0, 2048);
    add(da_w_in, p.w_da_v, 3072, D, 1024, 2048, 0, 1024);
    add(da_w_out, p.w_da_out, D, D, D, 0, 0, D);
    add(gla_w_in, p.w_gla_main, 3088, D, 1024, 0, 0, 1024);
    add(gla_w_in, p.w_gla_main + (size_t)1024 * D, 3088, D, 1024, 2048, 0, 1024);
    add(gla_w_in, p.w_gla_main + (size_t)2048 * D, 3088, D, 256, 3072, 0, 16);
    add(gla_w_in, p.w_gla_v, 3088, D, 1024, 1024, 0, 1024);
    add(gla_w_out, p.w_gla_out, D, D, D, 0, 0, D);
    p.njobs = nj; p.ntiles_prep = tiles;

    static int grid_blocks = 0;
    if (!grid_blocks) {
        (void)hipFuncSetAttribute((const void*)fwd_megakernel, hipFuncAttributeMaxDynamicSharedMemorySize, LDS_TOTAL);
        int dev = 0, cus = 0, per_cu = 0;
        (void)hipGetDevice(&dev);
        (void)hipDeviceGetAttribute(&cus, hipDeviceAttributeMultiprocessorCount, dev);
        (void)hipOccupancyMaxActiveBlocksPerMultiprocessor(&per_cu, fwd_megakernel, 512, LDS_TOTAL);
        if (per_cu > 1) per_cu = 1;
        grid_blocks = cus * per_cu;
        if (grid_blocks <= 0) grid_blocks = 256;
    }
#if N_LAUNCH_MODE == 1
    for (int ph = 0; ph < NPHASES; ++ph) {
        p.ph_lo = ph; p.ph_hi = ph + 1;
        hipLaunchKernelGGL(fwd_megakernel, dim3(grid_blocks), dim3(512), LDS_TOTAL, stream, p);
    }
#else
    p.ph_lo = 0; p.ph_hi = NPHASES;
    (void)hipMemsetAsync(p.bar, 0, (size_t)XCD_BAR_WORDS * 4, stream);
    void* args[] = {(void*)&p};
    hipError_t e = hipLaunchCooperativeKernel((const void*)fwd_megakernel, dim3(grid_blocks), dim3(512), args, LDS_TOTAL, stream);
    if (e != hipSuccess) fprintf(stderr, "cooperative launch failed: %s (grid %d)\n", hipGetErrorString(e), grid_blocks);
#endif
}
```
